# Optimizing an MI355X kernel written in HIP

```python
import jax, jax.numpy as jnp
from jax import lax
import numpy as np

D_MODEL = 1024
BATCH = 16
SEQ = 256
DEPTH = 4
DEC_BATCH = 2
DEC_SEQ = 4096
PAST_LEN = 256

GRID_W = 64
N_MIXERS = 2
N_POOL_LAYERS = (DEPTH + 1) // 2
N_RET_LAYERS = DEPTH // 2
POOL_WINDOWS = (2, 4, 8, 16)
POOL_GROUPS = 4
POOL_GC = D_MODEL // POOL_GROUPS
RET_HEADS = 4
RET_DK = D_MODEL // RET_HEADS
RET_DV = 2 * RET_DK
RET_HK = RET_HEADS * RET_DK
RET_HV = RET_HEADS * RET_DV
RET_IN = 2 * RET_HK + 2 * RET_HV
RET_CHUNK = 128
D_FF = 4 * D_MODEL
ROPE_BASE = 10000.0
NORM_EPS = 1e-6
GN_EPS = 1e-5
N_MOD = 6

kernel_name = "hybrid_pool_retention_diffusion_step"


def rmsnorm(x, w):
    xf = x.astype(jnp.float32)
    y = xf * lax.rsqrt(jnp.mean(jnp.square(xf), axis=-1, keepdims=True) + NORM_EPS)
    return (y * w.astype(jnp.float32)).astype(x.dtype)


def pool_mean_1d(x, w, axis):
    L = x.shape[axis]
    cs = jnp.cumsum(x.astype(jnp.float32), axis=axis)
    cs = jnp.pad(cs, [(1, 0) if a == axis else (0, 0) for a in range(x.ndim)])
    t = jnp.arange(L)
    lo = jnp.clip(t - w // 2, 0, L)
    hi = jnp.clip(t - w // 2 + w, 0, L)
    s = jnp.take(cs, hi, axis=axis) - jnp.take(cs, lo, axis=axis)
    cnt_shape = [L if a == axis else 1 for a in range(x.ndim)]
    cnt = (hi - lo).astype(jnp.float32).reshape(cnt_shape)
    return s / cnt


def pool_mixer(h, pw, pb, ps, grid):
    B, L, _ = h.shape
    outs = []
    for g, w in enumerate(POOL_WINDOWS):
        xg = h[..., g * POOL_GC:(g + 1) * POOL_GC]
        if grid:
            rows = L // GRID_W
            xr = xg.reshape(B, rows, GRID_W, POOL_GC)
            m = pool_mean_1d(pool_mean_1d(xr, w, 1), w, 2).reshape(B, L, POOL_GC)
        else:
            m = pool_mean_1d(xg, w, 1)
        d = (m - xg.astype(jnp.float32)).astype(h.dtype)
        outs.append(d @ pw[g] + pb[g])
    return jnp.concatenate(outs, axis=-1) * ps


def rope_2d(x):
    L = x.shape[2]
    t = jnp.arange(L)
    row = (t // GRID_W).astype(jnp.float32)
    col = (t % GRID_W).astype(jnp.float32)
    half = RET_DK // 2
    quarter = half // 2
    freqs = ROPE_BASE ** (-jnp.arange(quarter, dtype=jnp.float32) / quarter)

    def rot(xa, pos):
        ang = pos[:, None] * freqs[None, :]
        cos = jnp.cos(ang).astype(x.dtype)
        sin = jnp.sin(ang).astype(x.dtype)
        x1, x2 = xa[..., :quarter], xa[..., quarter:]
        return jnp.concatenate([x1 * cos - x2 * sin, x2 * cos + x1 * sin], axis=-1)

    return jnp.concatenate([rot(x[..., :half], row), rot(x[..., half:], col)], axis=-1)


def retention_chunked(q, k, v, log_gamma, s0, strict):
    b, h, L, _ = q.shape
    dv = v.shape[-1]
    n = L // RET_CHUNK

    def to_chunks(a):
        return jnp.moveaxis(a.astype(jnp.float32).reshape(b, h, n, RET_CHUNK, a.shape[-1]), 2, 0)

    qc, kc, vc = to_chunks(q), to_chunks(k), to_chunks(v)
    idx = jnp.arange(RET_CHUNK, dtype=jnp.float32)
    diff = idx[:, None] - idx[None, :]
    mask = (diff > 0) if strict else (diff >= 0)
    lg = log_gamma.astype(jnp.float32)
    dmat = jnp.where(mask[None], jnp.exp(lg[:, None, None] * jnp.maximum(diff, 0.0)[None]), 0.0)
    xi = jnp.exp(lg[:, None] * (idx + 1.0)[None])[:, :, None]
    zeta = jnp.exp(lg[:, None] * (RET_CHUNK - 1.0 - idx)[None])[:, :, None]
    g_chunk = jnp.exp(lg * RET_CHUNK)[:, None, None]

    def step(S, inp):
        qb, kb, vb = inp
        scores = jnp.einsum('bhid,bhjd->bhij', qb, kb) * dmat
        o = jnp.einsum('bhij,bhje->bhie', scores, vb) + jnp.einsum('bhid,bhde->bhie', qb * xi, S)
        S = g_chunk * S + jnp.einsum('bhjd,bhje->bhde', kb * zeta, vb)
        return S, o

    s_fin, oc = lax.scan(step, s0.astype(jnp.float32), (qc, kc, vc))
    o = jnp.moveaxis(oc, 0, 2).reshape(b, h, L, dv)
    return o, s_fin


def retention_mixer(h, w_in, decay_exp, gn_w, w_out, s0_f, s0_b, grid):
    B, L, _ = h.shape
    proj = h @ w_in
    q, k, v, g = jnp.split(proj, [RET_HK, 2 * RET_HK, 2 * RET_HK + RET_HV], axis=-1)

    def heads(a, d):
        return a.reshape(B, L, RET_HEADS, d).transpose(0, 2, 1, 3)

    q = heads(q, RET_DK)
    k = heads(k, RET_DK) * (RET_DK ** -0.5)
    v = heads(v, RET_DV)
    if grid:
        q = rope_2d(q)
        k = rope_2d(k)
    lg = jnp.log1p(-jnp.exp2(-decay_exp.astype(jnp.float32)))
    o_f, s_f = retention_chunked(q, k, v, lg[0], s0_f, False)
    o_b, s_b = retention_chunked(q[:, :, ::-1], k[:, :, ::-1], v[:, :, ::-1], lg[1], s0_b, True)
    o = o_f + o_b[:, :, ::-1]
    mu = jnp.mean(o, axis=-1, keepdims=True)
    var = jnp.mean(jnp.square(o - mu), axis=-1, keepdims=True)
    o = (o - mu) * lax.rsqrt(var + GN_EPS) * gn_w.astype(jnp.float32)[:, None, :]
    o = o.transpose(0, 2, 1, 3).reshape(B, L, RET_HV).astype(h.dtype)
    out = (jax.nn.silu(g) * o) @ w_out
    return out, s_f, s_b


def sq_relu_mlp(h, w1, w2):
    return jnp.square(jax.nn.relu(h @ w1)) @ w2


def trunk(x, cond, state_ret, grid, w_ada, b_ada, norm_mix_w, norm_mlp_w, pool_w, pool_b,
          pool_scale, ret_w_in, ret_decay, ret_gn_w, ret_w_out, mlp_w1, mlp_w2, final_norm_w):
    B = x.shape[0]
    new_states = []
    for i in range(DEPTH):
        j = i // N_MIXERS
        mod = (jax.nn.silu(cond) @ w_ada[i] + b_ada[i])[:, None, :]
        sh_a, sc_a, g_a, sh_m, sc_m, g_m = jnp.split(mod, N_MOD, axis=-1)
        h = rmsnorm(x, norm_mix_w[i]) * (1 + sc_a) + sh_a
        if i % N_MIXERS == 0:
            mix = pool_mixer(h, pool_w[j], pool_b[j], pool_scale[j], grid)
        else:
            if state_ret is None:
                s0 = jnp.zeros((B, RET_HEADS, RET_DK, RET_DV), jnp.float32)
                s0_f, s0_b = s0, s0
            else:
                s0_f, s0_b = state_ret[:, j, 0], state_ret[:, j, 1]
            mix, s_f, s_b = retention_mixer(h, ret_w_in[j], ret_decay[j], ret_gn_w[j], ret_w_out[j],
                                            s0_f, s0_b, grid)
            if state_ret is None:
                new_states.append(jnp.stack([s_f, s_b], axis=1))
        x = x + g_a * mix
        h = rmsnorm(x, norm_mlp_w[i]) * (1 + sc_m) + sh_m
        x = x + g_m * sq_relu_mlp(h, mlp_w1[i], mlp_w2[i])
    y = rmsnorm(x, final_norm_w)
    if state_ret is None:
        return y, jnp.stack(new_states, axis=1)
    return y, None


def setup_inputs(seed: int = 0) -> dict:
    key = jax.random.key(seed)
    ks = jax.random.split(key, 20)
    f32 = jnp.float32
    nrm = lambda k, s: jax.random.normal(k, s, f32)
    return {
        "x_prompt": nrm(ks[0], (BATCH, SEQ, D_MODEL)),
        "x_sample": nrm(ks[1], (DEC_BATCH, DEC_SEQ, D_MODEL)),
        "state_ret": 0.5 * nrm(ks[2], (DEC_BATCH, N_RET_LAYERS, 2, RET_HEADS, RET_DK, RET_DV)),
        "c": nrm(ks[3], (DEC_BATCH, D_MODEL)),
        "c_ctx": nrm(ks[4], (D_MODEL,)),
        "w_ada": 0.5 * D_MODEL ** -0.5 * nrm(ks[5], (DEPTH, D_MODEL, N_MOD * D_MODEL)),
        "b_ada": 0.01 * nrm(ks[6], (DEPTH, N_MOD * D_MODEL)),
        "norm_mix_w": 1.0 + 0.05 * nrm(ks[7], (DEPTH, D_MODEL)),
        "norm_mlp_w": 1.0 + 0.05 * nrm(ks[8], (DEPTH, D_MODEL)),
        "pool_w": POOL_GC ** -0.5 * nrm(ks[9], (N_POOL_LAYERS, POOL_GROUPS, POOL_GC, POOL_GC)),
        "pool_b": 0.01 * nrm(ks[10], (N_POOL_LAYERS, POOL_GROUPS, POOL_GC)),
        "pool_scale": 1.0 + 0.1 * nrm(ks[11], (N_POOL_LAYERS, D_MODEL)),
        "ret_w_in": D_MODEL ** -0.5 * nrm(ks[12], (N_RET_LAYERS, D_MODEL, RET_IN)),
        "ret_decay": 5.0 + jnp.arange(RET_HEADS, dtype=f32)[None, None, :]
                     + 0.1 * nrm(ks[13], (N_RET_LAYERS, 2, RET_HEADS)),
        "ret_gn_w": 1.0 + 0.05 * nrm(ks[14], (N_RET_LAYERS, RET_HEADS, RET_DV)),
        "ret_w_out": RET_HV ** -0.5 * nrm(ks[15], (N_RET_LAYERS, RET_HV, D_MODEL)),
        "mlp_w1": D_MODEL ** -0.5 * nrm(ks[16], (DEPTH, D_MODEL, D_FF)),
        "mlp_w2": D_FF ** -0.5 * nrm(ks[17], (DEPTH, D_FF, D_MODEL)),
        "final_norm_w": 1.0 + 0.05 * nrm(ks[18], (D_MODEL,)),
    }


def reference(x_prompt, x_sample, state_ret, c, c_ctx, w_ada, b_ada, norm_mix_w, norm_mlp_w,
              pool_w, pool_b, pool_scale, ret_w_in, ret_decay, ret_gn_w, ret_w_out, mlp_w1,
              mlp_w2, final_norm_w):
    y_prompt, new_state_ret = trunk(x_prompt, c_ctx[None, :], None, False, w_ada, b_ada,
                                    norm_mix_w, norm_mlp_w, pool_w, pool_b, pool_scale, ret_w_in,
                                    ret_decay, ret_gn_w, ret_w_out, mlp_w1, mlp_w2, final_norm_w)
    y_sample, _ = trunk(x_sample, c, state_ret, True, w_ada, b_ada, norm_mix_w, norm_mlp_w,
                        pool_w, pool_b, pool_scale, ret_w_in, ret_decay, ret_gn_w, ret_w_out,
                        mlp_w1, mlp_w2, final_norm_w)
    return (y_prompt, y_sample, new_state_ret)
```

```cpp
#include <hip/hip_runtime.h>
#include <hip/hip_cooperative_groups.h>
#include <cstdio>
#include <cstdint>
namespace cg = cooperative_groups;

#define LAS __attribute__((address_space(3)))
typedef unsigned short bf16_t;
typedef short bf16x8 __attribute__((ext_vector_type(8)));
typedef float f32x4 __attribute__((ext_vector_type(4)));
typedef float f32x2 __attribute__((ext_vector_type(2)));
typedef unsigned u32x4 __attribute__((ext_vector_type(4)));
typedef unsigned u32x2 __attribute__((ext_vector_type(2)));

constexpr int D = 1024, FF = 4096, T_CTX = 4096, T = 12288, RIN = 6144, HV = 2048, NMOD = 6144;
constexpr float NORM_EPS = 1e-6f, GN_EPS = 1e-5f;
constexpr int NWAVES = 8, NTHREADS = 512;
constexpr size_t MiB = 1u << 20;
constexpr size_t WS_W1T = 0, WS_W2T = 32 * MiB, WS_WINT = 64 * MiB, WS_WOUTT = 88 * MiB, WS_PWT = 96 * MiB, WS_MODP = 97 * MiB, WS_MOD = 102 * MiB,
                 WS_TAB = 103 * MiB, WS_X = 104 * MiB, WS_HB = 152 * MiB, WS_Q = 176 * MiB, WS_K = 200 * MiB, WS_V = 224 * MiB, WS_G = 272 * MiB,
                 WS_O = 320 * MiB, WS_VT = 416 * MiB, WS_SBUF = 464 * MiB, WS_END = 624 * MiB;
constexpr size_t WS_KT = WS_O + 48 * MiB  , WS_DBUF = WS_G, WS_A = WS_O, WS_HF32 = WS_O, WS_VS = WS_O + 48 * MiB, WS_H = WS_SBUF;
constexpr size_t WS_BAR = WS_MOD + 512 * 1024;
constexpr size_t WS_ROWSS = WS_TAB + 128 * 1024;
constexpr size_t WS_BIASP = WS_VS, WS_BIASU = WS_MOD + 528 * 1024, WS_BIASI = WS_BIASU + 4 * 3 * 4096 * 4;
constexpr size_t TAB_ROPE = 0, TAB_POW = 65536;
constexpr int LDS_BYTES = 151 * 1024, LDS_BAR_OFF = 150 * 1024;

struct Params { const float* in[19]; float* out; unsigned char* ws; int ph_lo, ph_hi; };
enum { I_XP = 0, I_XS, I_STATE, I_C, I_CCTX, I_WADA, I_BADA, I_NMIX, I_NMLP, I_PW, I_PB, I_PS, I_WIN, I_DECAY, I_GNW, I_WOUT, I_W1, I_W2, I_FNW };

__device__ __forceinline__ int tid_from_wave(int wave0) { return wave0 * 64 + (int)__builtin_amdgcn_mbcnt_hi(~0u, __builtin_amdgcn_mbcnt_lo(~0u, 0u)); }
__device__ __forceinline__ float bf2f(unsigned h) { return __builtin_bit_cast(float, h << 16); }
__device__ __forceinline__ unsigned cvt_pk_bf16(float lo, float hi) { unsigned r; asm volatile("v_cvt_pk_bf16_f32 %0, %1, %2" : "=v"(r) : "v"(lo), "v"(hi)); return r; }
__device__ __forceinline__ float wave_sum(float v) {
#pragma unroll
    for (int o = 1; o < 64; o <<= 1) v += __shfl_xor(v, o);
    return v;
}
__device__ __forceinline__ float silu_f(float v) { return v / (1.f + __expf(-v)); }
__device__ __forceinline__ int perm8(int L) { return (L & ~31) | (((L >> 2) & 1) << 4) | (((L >> 3) & 3) << 2) | (L & 3); }
__device__ __forceinline__ int permrope(int L) { return (L & ~127) | (((L >> 4) & 3) << 5) | (((L >> 6) & 1) << 4) | (L & 15); }
__device__ __forceinline__ int cv_of_row(int row) { return row < T_CTX ? 0 : 1 + ((row - T_CTX) >> 12); }

namespace pg8 {
#define PG8_LAS __attribute__((address_space(3)))
typedef unsigned short bf16_t;
typedef short bf16x8 __attribute__((ext_vector_type(8)));
typedef float f32x4 __attribute__((ext_vector_type(4)));
typedef unsigned u32x4 __attribute__((ext_vector_type(4)));
constexpr int BM = 256, BK = 64, HALF = 128, HTB = HALF * BK * 2  , STAGE_BYTES = 8 * HTB, NXCD = 8, WGM = 8;

__host__ __device__ __forceinline__ int lds_byte(int r, int c) { const int st = (r >> 4) * 2 + (c >> 5), rr = r & 15, cc = c & 31, ob = rr * 64 + cc * 2; return st * 1024 + (ob ^ (((ob >> 9) & 1) << 5)); }
__host__ __device__ __forceinline__ void stage_rc(int b, int& R, int& C) { const int st = b / 1024, sb = b % 1024, swz = sb ^ (((sb >> 9) & 1) << 5); R = (st >> 1) * 16 + swz / 64; C = (st & 1) * 32 + (swz % 64) / 2; }
__host__ __device__ __forceinline__ int perm32(int rho) { const int n = rho >> 4, i = rho & 15; return 8 * (i >> 2) + 4 * n + (i & 3); }

struct Unit { int pm, pn; };
struct Gemm { const bf16_t* A; const bf16_t* Bt; int M, N, K; };

struct StaticOrder {
    int nM, nN, nwg, G, c;
    __host__ __device__ void init(int M, int N, int G_, int c_) { nM = M / BM; nN = N / BM; nwg = nM * nN; G = G_; c = c_; }
    __host__ __device__ bool next(int i, Unit& u) const {
        const long L = (long)i * G + c; if (L >= nwg) return false;
        int wgid = (int)L; { const int q = nwg / NXCD, r = nwg % NXCD, xcd = wgid % NXCD, off = wgid / NXCD; wgid = (xcd < r ? xcd * (q + 1) : r * (q + 1) + (xcd - r) * q) + off; }
        const int nig = WGM * nN, gid = wgid / nig, fm = gid * WGM, gsz = (nM - fm) < WGM ? (nM - fm) : WGM;
        u.pm = fm + ((wgid % nig) % gsz); u.pn = (wgid % nig) / gsz; return true;
    }
    __device__ __forceinline__ void a_ready(const Unit&) const {}
    __device__ __forceinline__ void done(const Unit&) const {}
};

__device__ __forceinline__ unsigned cvt_pk_bf16(float lo, float hi) { unsigned r; asm volatile("v_cvt_pk_bf16_f32 %0, %1, %2" : "=v"(r) : "v"(lo), "v"(hi)); return r; }

struct PoolOrder {
    int G, c;
    __device__ bool next(int i, Unit& u) const { const long L = (long)i * G + c; if (L >= 192) return false; u.pm = (int)L; u.pn = (int)L / 48; return true; }
    __device__ __forceinline__ void a_ready(const Unit&) const {}
    __device__ __forceinline__ void done(const Unit&) const {}
};
struct InprojOrder {
    StaticOrder L, C; int G, c;
    __device__ void init(int G_, int c_) { G = G_; c = c_; L.init(8192, 6144, G_, c_); C.init(4096, 4096, G_, c_); }
    __device__ bool next(int i, Unit& u) const { const long id = (long)i * G + c; if (id >= 1024) return false;
        if (id < 768) { StaticOrder t = L; t.c = (int)(id % G); if (!t.next((int)(id / G), u)) return false; u.pm += 16; return true; }
        const long k = id - 768; StaticOrder t = C; t.c = (int)(k % G); return t.next((int)(k / G), u); }
    __device__ __forceinline__ void a_ready(const Unit&) const {}
    __device__ __forceinline__ void done(const Unit&) const {}
};
struct SingleOrder { int pm, pn;
    __device__ bool next(int i, Unit& u) const { if (i > 0) return false; u.pm = pm; u.pn = pn; return true; }
    __device__ __forceinline__ void a_ready(const Unit&) const {}
    __device__ __forceinline__ void done(const Unit&) const {}
};
struct EpiUp {
    static constexpr bool PERM = false, AFTER_DRAIN = false;
    bf16_t* H; const PG8_LAS float* tab; mutable int ord;
    __device__ __forceinline__ void operator()(const f32x4 (&acc)[2][2][4][2], const Unit& u, int wr, int wc, int fr, int fq) const {
        const int row0 = u.pm * BM + wr * 64 + fr, col0 = u.pn * BM + wc * 32 + 8 * fq;
        const PG8_LAS float* rt = tab + ord * 512 + wr * 64 + fr; const PG8_LAS float* bt = tab + ord * 512 + 256 + wc * 32 + 8 * fq; ++ord;
#pragma unroll
        for (int bj = 0; bj < 2; ++bj) { const f32x4 b0 = *(const PG8_LAS f32x4*)(bt + bj * HALF), b1 = *(const PG8_LAS f32x4*)(bt + bj * HALF + 4);
#pragma unroll
            for (int ai = 0; ai < 2; ++ai)
#pragma unroll
                for (int m = 0; m < 4; ++m) { const float rs = rt[ai * HALF + m * 16]; f32x4 v0 = acc[ai][bj][m][0] * rs + b0, v1 = acc[ai][bj][m][1] * rs + b1;
#pragma unroll
                    for (int j = 0; j < 4; ++j) { const float a = fmaxf(v0[j], 0.f), b = fmaxf(v1[j], 0.f); v0[j] = a * a; v1[j] = b * b; }
                    u32x4 w; w.x = cvt_pk_bf16(v0[0], v0[1]); w.y = cvt_pk_bf16(v0[2], v0[3]); w.z = cvt_pk_bf16(v1[0], v1[1]); w.w = cvt_pk_bf16(v1[2], v1[3]);
                    *(u32x4*)(H + (size_t)(row0 + ai * HALF + m * 16) * 4096 + col0 + bj * HALF) = w; } }
    }
};
struct EpiRes {
    static constexpr bool PERM = false, AFTER_DRAIN = false;
    float* X; const float* gate;
    __device__ __forceinline__ void operator()(const f32x4 (&acc)[2][2][4][2], const Unit& u, int wr, int wc, int fr, int fq) const {
        const int row0 = u.pm * BM + wr * 64 + fr, col0 = u.pn * BM + wc * 32 + 8 * fq;
        const int cv = u.pm < 16 ? 0 : (u.pm < 32 ? 1 : 2);
#pragma unroll
        for (int bj = 0; bj < 2; ++bj)
#pragma unroll
            for (int n = 0; n < 2; ++n) {
                const int co = col0 + bj * HALF + 4 * n;
                const f32x4 gv = *(const f32x4*)(gate + cv * 6144 + co);
#pragma unroll
                for (int ai = 0; ai < 2; ++ai)
#pragma unroll
                    for (int m = 0; m < 4; ++m) { f32x4* px = (f32x4*)(X + (size_t)(row0 + ai * HALF + m * 16) * 1024 + co); f32x4 xv = *px; xv = xv + gv * acc[ai][bj][m][n]; *px = xv; } }
    }
};
struct EpiRes192 {
    static constexpr bool PERM = false, AFTER_DRAIN = false;
    float* X; int nh; bf16_t* HB; float* rowss; const PG8_LAS float* tab; mutable int ord;
    __device__ __forceinline__ void operator()(const f32x4 (&acc)[2][2][3][2], const Unit& u, int wr, int wc, int fr, int fq) const {
        const int row0 = u.pm * 192 + wr * 48 + fr, col0 = u.pn * BM + wc * 32 + 8 * fq;
        const PG8_LAS float* tb = tab + ord * 1536 + wc * 32 + 8 * fq; ++ord;
        float ss[2][3];
#pragma unroll
        for (int ai = 0; ai < 2; ++ai)
#pragma unroll
            for (int m = 0; m < 3; ++m) ss[ai][m] = 0.f;
#pragma unroll
        for (int bj = 0; bj < 2; ++bj) {
            f32x4 xin[2][2][3];
#pragma unroll
            for (int n = 0; n < 2; ++n)
#pragma unroll
                for (int ai = 0; ai < 2; ++ai)
#pragma unroll
                    for (int m = 0; m < 3; ++m) xin[n][ai][m] = *(const f32x4*)(X + (size_t)(row0 + ai * 96 + m * 16) * 1024 + col0 + bj * HALF + 4 * n);
#pragma unroll
            for (int n = 0; n < 2; ++n) {
                const int co = col0 + bj * HALF + 4 * n, cl = bj * HALF + 4 * n;
                const f32x4 g0 = *(const PG8_LAS f32x4*)(tb + cl), g1 = *(const PG8_LAS f32x4*)(tb + 256 + cl), g2 = *(const PG8_LAS f32x4*)(tb + 512 + cl);
                const f32x4 w0 = *(const PG8_LAS f32x4*)(tb + 768 + cl), w1 = *(const PG8_LAS f32x4*)(tb + 1024 + cl), w2 = *(const PG8_LAS f32x4*)(tb + 1280 + cl);
#pragma unroll
                for (int ai = 0; ai < 2; ++ai)
#pragma unroll
                    for (int m = 0; m < 3; ++m) { const int row = row0 + ai * 96 + m * 16; const f32x4 gv = row < 4096 ? g0 : (row < 8192 ? g1 : g2);
                        f32x4 xv = xin[n][ai][m]; xv = xv + gv * acc[ai][bj][m][n]; *(f32x4*)(X + (size_t)row * 1024 + co) = xv;
                        if (nh) { const f32x4 wv = row < 4096 ? w0 : (row < 8192 ? w1 : w2); const f32x4 y = xv * wv;
                            ss[ai][m] += (xv[0] * xv[0] + xv[1] * xv[1]) + (xv[2] * xv[2] + xv[3] * xv[3]);
                            u32x2 o; o.x = cvt_pk_bf16(y[0], y[1]); o.y = cvt_pk_bf16(y[2], y[3]); *(u32x2*)(HB + (size_t)row * 1024 + co) = o; } } } }
        if (nh) {
#pragma unroll
            for (int ai = 0; ai < 2; ++ai)
#pragma unroll
                for (int m = 0; m < 3; ++m) { float v = ss[ai][m]; v += __shfl_xor(v, 16); v += __shfl_xor(v, 32);
                    if (fq == 0) rowss[(size_t)(row0 + ai * 96 + m * 16) * 16 + u.pn * 4 + wc] = v; } }
    }
};
struct EpiFinal192 {
    static constexpr bool PERM = false, AFTER_DRAIN = true;
    const float* X; float* out; const float* fnw; const PG8_LAS float* tab; unsigned* gstat; unsigned* gflag;
    __device__ __forceinline__ void operator()(const f32x4 (&)[2][2][3][2], const Unit&, int, int, int, int) const {}
    __device__ __forceinline__ void fused(const f32x4 (&acc)[2][2][3][2], const Unit& u, int wr, int wc, int fr, int fq, PG8_LAS unsigned char* lds, int wid, int lane) const {
        const int row0 = u.pm * 192 + wr * 48 + fr, col0 = u.pn * BM + wc * 32 + 8 * fq;
        const PG8_LAS float* tb = tab + wc * 32 + 8 * fq;
        PG8_LAS float* red = (PG8_LAS float*)lds;
        PG8_LAS float* rsl = (PG8_LAS float*)(lds + 4096);
        const int tid = wid * 64 + lane;
        f32x4 xv[2][2][2][3]; float ss[2][3];
#pragma unroll
        for (int ai = 0; ai < 2; ++ai)
#pragma unroll
            for (int m = 0; m < 3; ++m) ss[ai][m] = 0.f;
#pragma unroll
        for (int bj = 0; bj < 2; ++bj) {
#pragma unroll
            for (int n = 0; n < 2; ++n)
#pragma unroll
                for (int ai = 0; ai < 2; ++ai)
#pragma unroll
                    for (int m = 0; m < 3; ++m) xv[bj][n][ai][m] = *(const f32x4*)(X + (size_t)(row0 + ai * 96 + m * 16) * 1024 + col0 + bj * HALF + 4 * n);
#pragma unroll
            for (int n = 0; n < 2; ++n) { const int cl = bj * HALF + 4 * n;
                const f32x4 g0 = *(const PG8_LAS f32x4*)(tb + cl), g1 = *(const PG8_LAS f32x4*)(tb + 256 + cl), g2 = *(const PG8_LAS f32x4*)(tb + 512 + cl);
#pragma unroll
                for (int ai = 0; ai < 2; ++ai)
#pragma unroll
                    for (int m = 0; m < 3; ++m) { const int row = row0 + ai * 96 + m * 16; const f32x4 gv = row < 4096 ? g0 : (row < 8192 ? g1 : g2);
                        const f32x4 x = xv[bj][n][ai][m] + gv * acc[ai][bj][m][n]; xv[bj][n][ai][m] = x;
                        ss[ai][m] += (x[0] * x[0] + x[1] * x[1]) + (x[2] * x[2] + x[3] * x[3]); } } }
#pragma unroll
        for (int ai = 0; ai < 2; ++ai)
#pragma unroll
            for (int m = 0; m < 3; ++m) { float v = ss[ai][m]; v += __shfl_xor(v, 16); v += __shfl_xor(v, 32);
                if (fq == 0) red[(wr * 48 + ai * 96 + m * 16 + fr) * 4 + wc] = v; }
        __syncthreads();
        const int unit = u.pm * 4 + u.pn; float part = 0.f;
        if (tid < 192) { part = (red[tid * 4] + red[tid * 4 + 1]) + (red[tid * 4 + 2] + red[tid * 4 + 3]);
            __hip_atomic_store(gstat + (size_t)unit * 192 + tid, __builtin_bit_cast(unsigned, part), __ATOMIC_RELAXED, __HIP_MEMORY_SCOPE_AGENT); }
        asm volatile("s_waitcnt vmcnt(0)" ::: "memory");
        __syncthreads();
        if (tid == 0) {
            __hip_atomic_store(gflag + unit, 1u, __ATOMIC_RELAXED, __HIP_MEMORY_SCOPE_AGENT);
#pragma unroll
            for (int q = 0; q < 4; ++q) { unsigned sp = 0;
                while (__hip_atomic_load(gflag + u.pm * 4 + q, __ATOMIC_RELAXED, __HIP_MEMORY_SCOPE_AGENT) != 1u) { __builtin_amdgcn_s_sleep(2); if (++sp > (1u << 20)) break; } }
            __builtin_amdgcn_fence(__ATOMIC_ACQUIRE, "agent");
            asm volatile("s_waitcnt vmcnt(0)" ::: "memory"); }
        __syncthreads();
        if (tid < 192) { float tot = 0.f;
#pragma unroll
            for (int q = 0; q < 4; ++q) tot += (q == u.pn) ? part : __builtin_bit_cast(float, __hip_atomic_load(gstat + (size_t)(u.pm * 4 + q) * 192 + tid, __ATOMIC_RELAXED, __HIP_MEMORY_SCOPE_AGENT));
            rsl[tid] = rsqrtf(tot * (1.f / 1024.f) + 1e-6f); }
        __syncthreads();
#pragma unroll
        for (int bj = 0; bj < 2; ++bj)
#pragma unroll
            for (int n = 0; n < 2; ++n) { const int co = col0 + bj * HALF + 4 * n; const f32x4 wv = *(const f32x4*)(fnw + co);
#pragma unroll
                for (int ai = 0; ai < 2; ++ai)
#pragma unroll
                    for (int m = 0; m < 3; ++m) { const int rl = wr * 48 + ai * 96 + m * 16 + fr; const f32x4 y = xv[bj][n][ai][m] * rsl[rl] * wv;
                        __builtin_nontemporal_store(y, (f32x4*)(out + (size_t)(u.pm * 192 + rl) * 1024 + co)); } }
    }
};
struct EpiPool {
    static constexpr bool PERM = false, AFTER_DRAIN = false;
    float* X; const float* xp; const float* xs; int first; const float* gate; const float* pb; const float* ps; const float* nw; const float* sc; bf16_t* HB; float* rowss;
    __device__ __forceinline__ void operator()(const f32x4 (&acc)[2][2][4][2], const Unit& u, int wr, int wc, int fr, int fq) const {
        const int g = u.pn, tile = u.pm - g * 48;
        const int row0 = tile * BM + wr * 64 + fr, col0 = g * BM + wc * 32 + 8 * fq;
        const int cv = tile < 16 ? 0 : (tile < 32 ? 1 : 2);
        const float* xold = first ? (tile < 16 ? xp : xs - (size_t)T_CTX * 1024) : X;
#pragma unroll
        for (int ai = 0; ai < 2; ++ai)
#pragma unroll
            for (int m = 0; m < 4; ++m) { const int row = row0 + ai * HALF + m * 16; float ssv = 0.f;
                f32x4 xin[2][2];
#pragma unroll
                for (int bj = 0; bj < 2; ++bj)
#pragma unroll
                    for (int n = 0; n < 2; ++n) xin[bj][n] = *(const f32x4*)(xold + (size_t)row * 1024 + col0 + bj * HALF + 4 * n);
#pragma unroll
                for (int bj = 0; bj < 2; ++bj)
#pragma unroll
                    for (int n = 0; n < 2; ++n) { const int co = col0 + bj * HALF + 4 * n; const size_t ro = (size_t)row * 1024 + co;
                        const f32x4 gv = *(const f32x4*)(gate + cv * 6144 + co), bv = *(const f32x4*)(pb + co), sv = *(const f32x4*)(ps + co);
                        const f32x4 wv = *(const f32x4*)(nw + co) * (*(const f32x4*)(sc + cv * 6144 + co) + 1.f);
                        f32x4 xv = xin[bj][n]; xv = xv + gv * ((acc[ai][bj][m][n] + bv) * sv); *(f32x4*)(X + ro) = xv;
                        const f32x4 y = xv * wv; ssv += (xv[0] * xv[0] + xv[1] * xv[1]) + (xv[2] * xv[2] + xv[3] * xv[3]);
                        u32x2 o; o.x = cvt_pk_bf16(y[0], y[1]); o.y = cvt_pk_bf16(y[2], y[3]); *(u32x2*)(HB + ro) = o; }
                ssv += __shfl_xor(ssv, 16); ssv += __shfl_xor(ssv, 32);
                if (fq == 0) rowss[(size_t)row * 16 + g * 4 + wc] = ssv; }
    }
};
struct EpiInproj {
    static constexpr bool PERM = false, AFTER_DRAIN = false;
    bf16_t *Q, *K, *V, *Gt; const float* rope; const PG8_LAS float* tab; mutable int ord;
    __device__ __forceinline__ void operator()(const f32x4 (&acc)[2][2][4][2], const Unit& u, int wr, int wc, int fr, int fq) const {
        const int pn = u.pn, row0 = u.pm * BM + wr * 64 + fr;
        const PG8_LAS float* rt = tab + ord * 512 + wr * 64 + fr; const PG8_LAS float* bp = tab + ord * 512 + 256; ++ord;
        float rstd[2][4];
#pragma unroll
        for (int ai = 0; ai < 2; ++ai)
#pragma unroll
            for (int m = 0; m < 4; ++m) rstd[ai][m] = rt[ai * HALF + m * 16];
        if (pn < 8) {
            bf16_t* dst = (pn < 4 ? Q : K) + (pn & 3) * 256;
            const float sc = pn < 4 ? 1.f : 0.0625f;
            const bool lat = u.pm >= 16;
            const int i0 = 16 * wc + 4 * fq;
#pragma unroll
            for (int ai = 0; ai < 2; ++ai)
#pragma unroll
                for (int m = 0; m < 4; ++m) { const int row = row0 + ai * HALF + m * 16; const int t = (row - T_CTX) & 4095;
#pragma unroll
                    for (int bj = 0; bj < 2; ++bj) { const int pos = bj ? (t & 63) : (t >> 6);
                        const f32x4 bb1 = *(const PG8_LAS f32x4*)(bp + bj * HALF + i0), bb2 = *(const PG8_LAS f32x4*)(bp + bj * HALF + 64 + i0);
                        f32x4 x1 = (acc[ai][bj][m][0] * rstd[ai][m] + bb1) * sc, x2 = (acc[ai][bj][m][1] * rstd[ai][m] + bb2) * sc, o1 = x1, o2 = x2;
                        if (lat) { const f32x4 c0 = *(const f32x4*)(rope + (size_t)(pos * 64 + i0) * 2), c1 = *(const f32x4*)(rope + (size_t)(pos * 64 + i0) * 2 + 4);
                            o1[0] = x1[0] * c0[0] - x2[0] * c0[1]; o2[0] = x2[0] * c0[0] + x1[0] * c0[1];
                            o1[1] = x1[1] * c0[2] - x2[1] * c0[3]; o2[1] = x2[1] * c0[2] + x1[1] * c0[3];
                            o1[2] = x1[2] * c1[0] - x2[2] * c1[1]; o2[2] = x2[2] * c1[0] + x1[2] * c1[1];
                            o1[3] = x1[3] * c1[2] - x2[3] * c1[3]; o2[3] = x2[3] * c1[2] + x1[3] * c1[3]; }
                        bf16_t* rp = dst + (size_t)row * 1024 + bj * HALF + i0;
                        u32x2 w1, w2; w1.x = cvt_pk_bf16(o1[0], o1[1]); w1.y = cvt_pk_bf16(o1[2], o1[3]); w2.x = cvt_pk_bf16(o2[0], o2[1]); w2.y = cvt_pk_bf16(o2[2], o2[3]);
                        *(u32x2*)rp = w1; *(u32x2*)(rp + 64) = w2; } }
        } else {
            bf16_t* dst = (pn < 16 ? V + (pn - 8) * 256 : Gt + (pn - 16) * 256) + wc * 32 + 8 * fq;
#pragma unroll
            for (int ai = 0; ai < 2; ++ai)
#pragma unroll
                for (int m = 0; m < 4; ++m) { bf16_t* rowp = dst + (size_t)(row0 + ai * HALF + m * 16) * 2048;
#pragma unroll
                    for (int bj = 0; bj < 2; ++bj) { const f32x4 b0 = *(const PG8_LAS f32x4*)(bp + bj * HALF + wc * 32 + 8 * fq), b1 = *(const PG8_LAS f32x4*)(bp + bj * HALF + wc * 32 + 8 * fq + 4);
                        const f32x4 v0 = acc[ai][bj][m][0] * rstd[ai][m] + b0, v1 = acc[ai][bj][m][1] * rstd[ai][m] + b1;
                        u32x4 w; w.x = cvt_pk_bf16(v0[0], v0[1]); w.y = cvt_pk_bf16(v0[2], v0[3]); w.z = cvt_pk_bf16(v1[0], v1[1]); w.w = cvt_pk_bf16(v1[2], v1[3]);
                        *(u32x4*)(rowp + bj * HALF) = w; } }
        }
    }
};
template <class Epi, class Sched, bool ALIGN_EPI = false, bool SP2 = false, int MF = 4>
__device__ __forceinline__ void gemm_phase(PG8_LAS unsigned char* lds, const Gemm g, const Sched& S, const Epi& E, int tid_in) {
    int tid_ = tid_in; asm volatile("" : "+v"(tid_)); const int tid = tid_, wid = __builtin_amdgcn_readfirstlane(tid >> 6), lane = tid & 63, wr = wid >> 2, wc = wid & 3, fr = lane & 15, fq = lane >> 4;
    const int K = g.K, nt = K / BK;
    unsigned voffA[2], voffB[2];
#pragma unroll
    for (int i = 0; i < 2; ++i) { int R, C; stage_rc(tid * 16 + i * 8192, R, C); const int Rb = Epi::PERM ? ((R & ~31) + perm32(R & 31)) : R;
        voffA[i] = (unsigned)(R * K + C) * 2u; voffB[i] = (unsigned)(Rb * K + C) * 2u; }
    const size_t kstep = (size_t)(BK * 2);
    const size_t hstep = (size_t)HALF * K * 2, hstepA = (size_t)(32 * MF) * K * 2;
    const size_t tstep = 2 * hstep, tstepA = 2 * hstepA;
    const unsigned ldsw = (unsigned)wid * 1024u;
    const int aoff = lds_byte(wr * (16 * MF) + fr, fq * 8), boff = lds_byte(wc * 32 + fr, fq * 8);
#define PG8_SA(b, h) (((b) * 2 + (h)) * HTB)
#define PG8_SB(b, h) ((4 + (b) * 2 + (h)) * HTB)
#define PG8_STAGE(bufoff, gbase, voff) do { _Pragma("unroll") for (int _i = 0; _i < 2; ++_i) \
        __builtin_amdgcn_global_load_lds((const unsigned*)((const char*)(gbase) + (voff)[_i]), (PG8_LAS unsigned*)(lds + (bufoff) + ldsw + _i * 8192), 16, 0, 0); } while (0)
#define PG8_LDA(dst, b, h) do { _Pragma("unroll") for (int m = 0; m < MF; ++m) _Pragma("unroll") for (int k = 0; k < 2; ++k) dst[m][k] = *(const PG8_LAS bf16x8*)(lds + PG8_SA(b, h) + aoff + m * 2048 + k * 1024); } while (0)
#define PG8_LDB(dst, b, h) do { _Pragma("unroll") for (int n = 0; n < 2; ++n) _Pragma("unroll") for (int k = 0; k < 2; ++k) dst[n][k] = *(const PG8_LAS bf16x8*)(lds + PG8_SB(b, h) + boff + n * 2048 + k * 1024); } while (0)
#define PG8_MMA(ai, bj, At, Bt) do { __builtin_amdgcn_s_setprio(1); _Pragma("unroll") for (int m = 0; m < MF; ++m) _Pragma("unroll") for (int n = 0; n < 2; ++n) _Pragma("unroll") for (int k = 0; k < 2; ++k) \
        acc[ai][bj][m][n] = __builtin_amdgcn_mfma_f32_16x16x32_bf16(Bt[n][k], At[m][k], acc[ai][bj][m][n], 0, 0, 0); __builtin_amdgcn_s_setprio(0); } while (0)
#define PG8_WAIT_V(n) asm volatile("s_waitcnt vmcnt(" #n ")" ::: "memory")
#define PG8_WAIT_L(n) asm volatile("s_waitcnt lgkmcnt(" #n ")" ::: "memory")
#define PG8_BAR __builtin_amdgcn_s_barrier()
#define PG8_SCHED __builtin_amdgcn_sched_barrier(0)
    Unit cur, nxt; int ui = 0;
    if (!S.next(0, cur)) return;
    f32x4 acc[2][2][MF][2];
#pragma unroll
    for (int a = 0; a < 2; ++a)
#pragma unroll
        for (int b = 0; b < 2; ++b)
#pragma unroll
            for (int m = 0; m < MF; ++m)
#pragma unroll
                for (int n = 0; n < 2; ++n) acc[a][b][m][n] = (f32x4){0.f, 0.f, 0.f, 0.f};
    bf16x8 At[MF][2], B0[2][2], B1[2][2];
    const char* cA = (const char*)g.A + (size_t)cur.pm * tstepA; const char* cB = (const char*)g.Bt + (size_t)cur.pn * tstep;
    S.a_ready(cur);
    if constexpr (SP2) {
        PG8_STAGE(PG8_SB(0, 0), cB, voffB); PG8_STAGE(PG8_SB(0, 1), cB + hstep, voffB); PG8_STAGE(PG8_SA(0, 0), cA, voffA); PG8_STAGE(PG8_SA(0, 1), cA + hstepA, voffA);
        if (wr == 1) PG8_BAR;
        PG8_WAIT_V(2); PG8_BAR;
        PG8_STAGE(PG8_SB(1, 0), cB + kstep, voffB); PG8_STAGE(PG8_SA(1, 0), cA + kstep, voffA); PG8_STAGE(PG8_SB(1, 1), cB + hstep + kstep, voffB);
        PG8_WAIT_V(6); PG8_BAR;
    } else {
        PG8_STAGE(PG8_SB(0, 0), cB, voffB); PG8_STAGE(PG8_SA(0, 0), cA, voffA); PG8_STAGE(PG8_SB(0, 1), cB + hstep, voffB); PG8_STAGE(PG8_SA(0, 1), cA + hstepA, voffA);
        if (wr == 1) PG8_BAR;
        PG8_WAIT_V(4); PG8_BAR;
        PG8_STAGE(PG8_SB(1, 0), cB + kstep, voffB); PG8_STAGE(PG8_SA(1, 0), cA + kstep, voffA); PG8_STAGE(PG8_SB(1, 1), cB + hstep + kstep, voffB);
        PG8_WAIT_V(6); PG8_BAR;
    }
    for (;;) {
        const bool has_next = S.next(ui + 1, nxt);
        const char* nA = has_next ? (const char*)g.A + (size_t)nxt.pm * tstepA : cA; const char* nB = has_next ? (const char*)g.Bt + (size_t)nxt.pn * tstep : cB;
        for (int t = 0; t < nt; t += 2) {
            const bool last = (t == nt - 2);
            const char* a1 = cA + (size_t)(t + 1) * kstep;
            const char* a2 = last ? nA : cA + (size_t)(t + 2) * kstep; const char* b2 = last ? nB : cB + (size_t)(t + 2) * kstep;
            const char* a3 = a2 + kstep; const char* b3 = b2 + kstep;
            if (last && has_next) S.a_ready(nxt);
            if constexpr (SP2) {
            PG8_LDB(B0, 0, 0); PG8_LDB(B1, 0, 1); PG8_SCHED; PG8_LDA(At, 0, 0); PG8_STAGE(PG8_SA(1, 1), a1 + hstepA, voffA);
            PG8_WAIT_V(8); PG8_WAIT_L(0); PG8_BAR; PG8_MMA(0, 0, At, B0); PG8_MMA(0, 1, At, B1); PG8_BAR; PG8_SCHED;
            PG8_LDA(At, 0, 1); PG8_STAGE(PG8_SB(0, 0), b2, voffB); PG8_STAGE(PG8_SB(0, 1), b2 + hstep, voffB); PG8_STAGE(PG8_SA(0, 0), a2, voffA);
            PG8_WAIT_V(8); PG8_WAIT_L(0); PG8_BAR; PG8_MMA(1, 0, At, B0); PG8_MMA(1, 1, At, B1); PG8_BAR; PG8_SCHED;
            PG8_LDB(B0, 1, 0); PG8_LDB(B1, 1, 1); PG8_SCHED; PG8_LDA(At, 1, 0); PG8_STAGE(PG8_SA(0, 1), a2 + hstepA, voffA);
            PG8_WAIT_V(8); PG8_WAIT_L(0); PG8_BAR; PG8_MMA(0, 0, At, B0); PG8_MMA(0, 1, At, B1); PG8_BAR; PG8_SCHED;
            PG8_LDA(At, 1, 1); PG8_STAGE(PG8_SB(1, 0), b3, voffB); PG8_STAGE(PG8_SB(1, 1), b3 + hstep, voffB); PG8_STAGE(PG8_SA(1, 0), a3, voffA);
            PG8_WAIT_V(8); PG8_WAIT_L(0); PG8_BAR; PG8_MMA(1, 0, At, B0); PG8_MMA(1, 1, At, B1); PG8_BAR; PG8_SCHED;
            } else {
            PG8_LDB(B0, 0, 0); PG8_SCHED; PG8_LDA(At, 0, 0); PG8_STAGE(PG8_SA(1, 1), a1 + hstepA, voffA);
            PG8_WAIT_L(8); PG8_BAR; PG8_WAIT_L(0); PG8_MMA(0, 0, At, B0); PG8_BAR; PG8_SCHED;
            PG8_LDB(B1, 0, 1); PG8_STAGE(PG8_SB(0, 0), b2, voffB);
            PG8_BAR; PG8_WAIT_L(0); PG8_MMA(0, 1, At, B1); PG8_BAR;
            PG8_LDA(At, 0, 1); PG8_STAGE(PG8_SA(0, 0), a2, voffA);
            PG8_BAR; PG8_WAIT_L(0); PG8_MMA(1, 0, At, B0); PG8_BAR; PG8_SCHED;
            PG8_STAGE(PG8_SB(0, 1), b2 + hstep, voffB);
            PG8_WAIT_V(6); PG8_BAR; PG8_MMA(1, 1, At, B1); PG8_BAR;
            PG8_LDB(B0, 1, 0); PG8_SCHED; PG8_LDA(At, 1, 0); PG8_STAGE(PG8_SA(0, 1), a2 + hstepA, voffA);
            PG8_WAIT_L(8); PG8_BAR; PG8_WAIT_L(0); PG8_MMA(0, 0, At, B0); PG8_BAR; PG8_SCHED;
            PG8_LDB(B1, 1, 1); PG8_STAGE(PG8_SB(1, 0), b3, voffB);
            PG8_BAR; PG8_WAIT_L(0); PG8_MMA(0, 1, At, B1); PG8_BAR;
            PG8_LDA(At, 1, 1); PG8_STAGE(PG8_SA(1, 0), a3, voffA);
            PG8_BAR; PG8_WAIT_L(0); PG8_MMA(1, 0, At, B0); PG8_BAR; PG8_SCHED;
            PG8_STAGE(PG8_SB(1, 1), b3 + hstep, voffB);
            PG8_WAIT_V(6); PG8_BAR; PG8_MMA(1, 1, At, B1); PG8_BAR;
            }
        }
        if constexpr (ALIGN_EPI) { if (wr == 0) PG8_BAR; }
        if constexpr (!Epi::AFTER_DRAIN) { E(acc, cur, wr, wc, fr, fq); S.done(cur); }
        if (!has_next) break;
#pragma unroll
        for (int a = 0; a < 2; ++a)
#pragma unroll
            for (int b = 0; b < 2; ++b)
#pragma unroll
                for (int m = 0; m < MF; ++m)
#pragma unroll
                    for (int n = 0; n < 2; ++n) acc[a][b][m][n] = (f32x4){0.f, 0.f, 0.f, 0.f};
        cur = nxt; cA = nA; cB = nB; ++ui;
        if constexpr (ALIGN_EPI) { if (wr == 1) PG8_BAR; }
    }
    PG8_WAIT_V(0);
    if constexpr (!ALIGN_EPI) { if (wr == 0) PG8_BAR; }
    PG8_BAR;
    if constexpr (Epi::AFTER_DRAIN) { E.fused(acc, cur, wr, wc, fr, fq, lds, wid, lane); S.done(cur); }
#undef PG8_SA
#undef PG8_SB
#undef PG8_STAGE
#undef PG8_LDA
#undef PG8_LDB
#undef PG8_MMA
#undef PG8_WAIT_V
#undef PG8_WAIT_L
#undef PG8_BAR
#undef PG8_SCHED
}
}
#define XB_TMO      128
#define XB_XCNT(j)  (256  + 64 * (j))
#define XB_XSUB(j)  (1280 + 64 * (j))
#define XB_XGEN(j)  (2304 + 64 * (j))
#define XB_TOP      3328
#define XB_TOPGEN   3392
#define XCD_BAR_WORDS 3456
#define XB_SPIN_CAP (1u << 18)

__device__ __forceinline__ unsigned xb_ld(unsigned* p)              { return __hip_atomic_load(p, __ATOMIC_RELAXED, __HIP_MEMORY_SCOPE_AGENT); }
__device__ __forceinline__ unsigned xb_add(unsigned* p, unsigned v) { return __hip_atomic_fetch_add(p, v, __ATOMIC_RELAXED, __HIP_MEMORY_SCOPE_AGENT); }
__device__ __forceinline__ unsigned xb_xcc_id() { return (unsigned)__builtin_amdgcn_s_getreg((3 << 11) | 20) & 0xFu; }
#define XB_SPIN(cond, bar) do { unsigned _sp = 0; while (cond) { __builtin_amdgcn_s_sleep(1); \
    if ((++_sp & 255u) == 0u) { if (xb_ld(&(bar)[XB_TMO])) break; if (_sp > XB_SPIN_CAP) { atomicAdd(&(bar)[XB_TMO], 1u); break; } } } } while (0)

struct XcdBarrier {
    int w0;
    unsigned* bar; unsigned x;
    volatile LAS unsigned* st;
};

__device__ __forceinline__ XcdBarrier xcd_barrier_post(unsigned* bar, volatile LAS unsigned* st) {
    XcdBarrier b; b.bar = bar; b.x = xb_xcc_id(); b.st = st;
    if (threadIdx.x == 0) (void)xb_add(&bar[XB_XCNT(b.x)], 1u);
    return b;
}
__device__ __forceinline__ void xcd_barrier_complete(unsigned* bar, unsigned x, unsigned& nloc, unsigned& nx) {
    const unsigned G = gridDim.x * gridDim.y * gridDim.z;
    unsigned sum, cnt, mine, sp = 0u;
    for (;;) {
        sum = 0u; cnt = 0u; mine = 0u;
#pragma unroll
        for (unsigned j = 0; j < 16; ++j) { const unsigned c = xb_ld(&bar[XB_XCNT(j)]); sum += c; cnt += (c > 0u) ? 1u : 0u; mine = (j == x) ? c : mine; }
        if (sum == G) break;
        __builtin_amdgcn_s_sleep(1);
        if ((++sp & 255u) == 0u) { if (xb_ld(&bar[XB_TMO])) break; if (sp > XB_SPIN_CAP) { atomicAdd(&bar[XB_TMO], 1u); break; } }
    }
    nloc = mine > 0u ? mine : 1u; nx = cnt > 0u ? cnt : 1u;
}

__device__ __forceinline__ void xcd_barrier(const XcdBarrier& b) {
    asm volatile("s_waitcnt vmcnt(0)" ::: "memory");
    __syncthreads();
    if (tid_from_wave(b.w0) == 0) {
        unsigned* bar = b.bar;
        __builtin_amdgcn_s_waitcnt(0);
        unsigned nloc = b.st[0], nx = b.st[1];
        if (nloc == 0u) { xcd_barrier_complete(bar, b.x, nloc, nx); b.st[0] = nloc; b.st[1] = nx; }
        const unsigned old = xb_add(&bar[XB_XSUB(b.x)], 1u);
        const unsigned gen = old / nloc;
        if (old + 1u == (gen + 1u) * nloc) {
            __builtin_amdgcn_fence(__ATOMIC_RELEASE, "agent");
            asm volatile("s_waitcnt vmcnt(0)" ::: "memory");
            const unsigned og = xb_add(&bar[XB_TOP], 1u);
            const unsigned tg = og / nx;
            if (og + 1u == (tg + 1u) * nx) xb_add(&bar[XB_TOPGEN], 1u);
            else XB_SPIN(xb_ld(&bar[XB_TOPGEN]) == tg, bar);
            __builtin_amdgcn_fence(__ATOMIC_ACQUIRE, "agent");
            xb_add(&bar[XB_XGEN(b.x)], 1u);
            asm volatile("s_waitcnt vmcnt(0)" ::: "memory");
        } else {
            XB_SPIN(xb_ld(&bar[XB_XGEN(b.x)]) == gen, bar);
            __builtin_amdgcn_fence(__ATOMIC_ACQUIRE, "agent");
            asm volatile("s_waitcnt vmcnt(0)" ::: "memory");
        }
    }
    __syncthreads();
}

struct Ctx { const Params* p; unsigned char* ws; float* out; LAS unsigned char* lds; int tid, lane, wave, gw, ngw, bid, G; };
__device__ __forceinline__ Ctx fresh_ctx(const Params* pp, LAS unsigned char* lds, int wave0);
__device__ __forceinline__ Ctx fresh_ctx(const Params* pp, LAS unsigned char* lds, int wave0) {
    Ctx c; c.p = pp; c.lds = lds;
    int tid = tid_from_wave(wave0); asm volatile("" : "+v"(tid));
    int bid = blockIdx.x; asm volatile("" : "+s"(bid));
    int G = gridDim.x; asm volatile("" : "+s"(G));
    unsigned char* ws = pp->ws; asm volatile("" : "+s"(ws));
    float* out = pp->out; asm volatile("" : "+s"(out));
    c.tid = tid; c.lane = tid & 63; c.wave = __builtin_amdgcn_readfirstlane(tid >> 6); c.bid = bid; c.G = G; c.ws = ws; c.out = out; c.gw = bid * NWAVES + c.wave; c.ngw = G * NWAVES;
    return c;
}
__device__ __forceinline__ const float* inp(const Ctx& c, int i) { asm volatile("" : "+s"(i)); return c.p->in[i]; }

__device__ __forceinline__ void p0_transpose_item(const float* W, int K, int N, bf16_t* WT, LAS float* scr, int item, int lane, int mode, const float* sh = nullptr, float* biasp = nullptr) {
    const int nblk = N / 32, kb = item / nblk, nb = item % nblk, k0 = 64 * kb, n0 = 32 * nb;
#pragma unroll 8
    for (int i = 0; i < 32; ++i) { const int kk = 2 * i + (lane >> 5); scr[kk * 33 + (lane & 31)] = W[(size_t)(k0 + kk) * N + n0 + (lane & 31)]; }
    if (sh) { LAS float* shl = scr + 64 * 33;
#pragma unroll
        for (int cvv = 0; cvv < 3; ++cvv) shl[cvv * 64 + lane] = sh[(size_t)cvv * NMOD + k0 + lane]; }
    asm volatile("s_waitcnt lgkmcnt(0)" ::: "memory");
    if (sh) { const LAS float* shl = scr + 64 * 33; const int n = lane & 31, kh = (lane >> 5) * 32; float a0 = 0.f, a1 = 0.f, a2 = 0.f;
#pragma unroll 8
        for (int kk = 0; kk < 32; ++kk) { const float wv = scr[(kh + kk) * 33 + n]; a0 += shl[kh + kk] * wv; a1 += shl[64 + kh + kk] * wv; a2 += shl[128 + kh + kk] * wv; }
        a0 += __shfl_xor(a0, 32); a1 += __shfl_xor(a1, 32); a2 += __shfl_xor(a2, 32);
        if (lane < 32) { float* o = biasp + (size_t)(kb * 3) * N + n0 + n; o[0] = a0; o[N] = a1; o[2 * (size_t)N] = a2; } }
    const int c = lane & 7;
#pragma unroll
    for (int j = 0; j < 4; ++j) { const int n = (lane >> 3) + 8 * j; const LAS float* s = scr + (8 * c) * 33 + n;
        u32x4 o; o.x = cvt_pk_bf16(s[0 * 33], s[1 * 33]); o.y = cvt_pk_bf16(s[2 * 33], s[3 * 33]); o.z = cvt_pk_bf16(s[4 * 33], s[5 * 33]); o.w = cvt_pk_bf16(s[6 * 33], s[7 * 33]);
        const int L = n0 + n, Pn = (mode == 1 && L < 2048) ? permrope(L) : perm8(L);
        *(u32x4*)(WT + (size_t)Pn * K + k0 + 8 * c) = o; }
    asm volatile("s_waitcnt lgkmcnt(0)" ::: "memory");
}
__device__ __forceinline__ void phase_p0(const Ctx& c) {
    unsigned char* ws = c.ws;
    { LAS float* sl = (LAS float*)c.lds;
      float* modp = (float*)(ws + WS_MODP);
      for (int u = c.bid; u < 768; u += c.G) {
        const int l = u / 192, rem = u % 192, kc = rem / 12, nb = rem % 12, n = nb * 512 + c.tid;
        __syncthreads();
        if (c.tid < 192) { const int cvv = c.tid >> 6, k = 64 * kc + (c.tid & 63); const float v = cvv == 0 ? inp(c, I_CCTX)[k] : inp(c, I_C)[(cvv - 1) * 1024 + k]; sl[c.tid] = silu_f(v); }
        __syncthreads();
        float a0 = 0.f, a1 = 0.f, a2 = 0.f; const float* w = inp(c, I_WADA) + ((size_t)l * 1024 + 64 * kc) * NMOD + n;
#pragma unroll 8
        for (int k = 0; k < 64; ++k) { const float wv = w[(size_t)k * NMOD]; a0 += sl[k] * wv; a1 += sl[64 + k] * wv; a2 += sl[128 + k] * wv; }
        float* o = modp + (size_t)((l * 16 + kc) * 3) * NMOD + n; o[0] = a0; o[NMOD] = a1; o[2 * NMOD] = a2;
      }
      __syncthreads();
    }
    { float* rope = (float*)(ws + WS_TAB + TAB_ROPE); float* pw = (float*)(ws + WS_TAB + TAB_POW);
      const int gt = c.bid * NTHREADS + c.tid, ngt = c.G * NTHREADS;
      for (int i = gt; i < 4096; i += ngt) { const int pos = i >> 6, fi = i & 63; const float fr = powf(10000.f, -(float)fi / 64.f); const float ang = (float)pos * fr; rope[2 * i] = cosf(ang); rope[2 * i + 1] = sinf(ang); }
      for (int i = gt; i < 16 * 132; i += ngt) { const int n = i % 132, q = i / 132; const float lg = log1pf(-exp2f(-inp(c, I_DECAY)[q])); pw[i] = expf(lg * (float)n); }
    }
    { LAS float* scr = (LAS float*)(c.lds + c.wave * 9216);
      constexpr int I2 = 2048, IOUT = 1024, IP = 32;
      constexpr int NIT = 4 * I2 + 2 * IOUT + 8 * IP;
      for (int it = c.gw; it < NIT; it += c.ngw) {
        int r = it;
        if (r < 4 * I2) { const int l = r / I2; p0_transpose_item(inp(c, I_W2) + (size_t)l * 4096 * 1024, 4096, 1024, (bf16_t*)(ws + WS_W2T) + (size_t)l * 1024 * 4096, scr, r % I2, c.lane, 0); continue; } r -= 4 * I2;
        if (r < 2 * IOUT) { const int l = r / IOUT; p0_transpose_item(inp(c, I_WOUT) + (size_t)l * HV * 1024, HV, 1024, (bf16_t*)(ws + WS_WOUTT) + (size_t)l * 1024 * HV, scr, r % IOUT, c.lane, 0); continue; } r -= 2 * IOUT;
        { const int l = r / IP; p0_transpose_item(inp(c, I_PW) + (size_t)l * 65536, 256, 256, (bf16_t*)(ws + WS_PWT) + (size_t)l * 65536, scr, r % IP, c.lane, 0); }
      }
    }
}
__device__ __forceinline__ void phase_p0c(const Ctx& c) {
    unsigned char* ws = c.ws; const float* mod = (const float*)(ws + WS_MOD); float* biasp = (float*)(ws + WS_BIASP);
    LAS float* scr = (LAS float*)(c.lds + c.wave * 9216);
    constexpr int I1 = 2048, IIN = 3072, NIT = 4 * I1 + 2 * IIN;
    for (int it = c.gw; it < NIT; it += c.ngw) {
        int r = it;
        if (r < 4 * I1) { const int l = r / I1; p0_transpose_item(inp(c, I_W1) + (size_t)l * 1024 * 4096, 1024, 4096, (bf16_t*)(ws + WS_W1T) + (size_t)l * 4096 * 1024, scr, r % I1, c.lane, 0,
                                                                   mod + (size_t)(l * 3) * NMOD + 3 * 1024, biasp + (size_t)l * 16 * 3 * 4096); continue; } r -= 4 * I1;
        { const int jr = r / IIN, l = 2 * jr + 1; p0_transpose_item(inp(c, I_WIN) + (size_t)jr * 1024 * RIN, 1024, RIN, (bf16_t*)(ws + WS_WINT) + (size_t)jr * RIN * 1024, scr, r % IIN, c.lane, 1,
                                                                   mod + (size_t)(l * 3) * NMOD, biasp + (size_t)4 * 16 * 3 * 4096 + (size_t)jr * 16 * 3 * RIN); }
    }
}
__device__ __forceinline__ void bias_finalize(const Ctx& c) {
    const float* biasp = (const float*)(c.ws + WS_BIASP); float* bu = (float*)(c.ws + WS_BIASU); float* bi = (float*)(c.ws + WS_BIASI);
    const int gt = c.bid * NTHREADS + c.tid, ngt = c.G * NTHREADS;
    for (int i = gt; i < 4 * 3 * 4096 + 2 * 3 * RIN; i += ngt) {
        const bool up = i < 4 * 3 * 4096; const int q = up ? i : i - 4 * 3 * 4096, N = up ? 4096 : RIN, n = q % N, cvv = (q / N) % 3, l = q / (3 * N);
        const float* src = biasp + (up ? (size_t)l * 16 * 3 * 4096 : (size_t)4 * 16 * 3 * 4096 + (size_t)l * 16 * 3 * RIN) + (size_t)cvv * N + n;
        float s = 0.f;
#pragma unroll
        for (int kb = 0; kb < 16; ++kb) s += src[(size_t)kb * 3 * N];
        (up ? bu : bi)[q] = s; }
}
__device__ __forceinline__ void phase_p0b(const Ctx& c) {
    const float* modp = (const float*)(c.ws + WS_MODP); float* mod = (float*)(c.ws + WS_MOD);
    const int gt = c.bid * NTHREADS + c.tid, ngt = c.G * NTHREADS;
    for (int i = gt; i < 4 * 3 * NMOD; i += ngt) { const int n = i % NMOD, cvv = (i / NMOD) % 3, l = i / (3 * NMOD);
        float s = inp(c, I_BADA)[l * NMOD + n];
#pragma unroll
        for (int kc = 0; kc < 16; ++kc) s += modp[(size_t)((l * 16 + kc) * 3 + cvv) * NMOD + n];
        mod[i] = s; }
}
template <int MODE> __device__ __forceinline__ void phase_norm(const Ctx& c, int l, int which, int from_input) {
    const float* X = (const float*)(c.ws + WS_X); const float* mod = (const float*)(c.ws + WS_MOD);
    const float* nw = MODE == 2 ? inp(c, I_FNW) : (which ? inp(c, I_NMLP) : inp(c, I_NMIX)) + l * 1024;
    for (int row = c.gw; row < T; row += c.ngw) {
        const float* xr = from_input ? (row < T_CTX ? inp(c, I_XP) + (size_t)row * 1024 : inp(c, I_XS) + (size_t)(row - T_CTX) * 1024) : X + (size_t)row * 1024;
        f32x4 v[4]; float ss = 0.f;
#pragma unroll
        for (int j = 0; j < 4; ++j) { v[j] = *(const f32x4*)(xr + 4 * c.lane + 256 * j); ss += (v[j][0] * v[j][0] + v[j][1] * v[j][1]) + (v[j][2] * v[j][2] + v[j][3] * v[j][3]); }
        const float rstd = rsqrtf(wave_sum(ss) * (1.f / 1024.f) + NORM_EPS);
        const float* mrow = mod + (size_t)(l * 3 + cv_of_row(row)) * NMOD + (which ? 3 : 0) * 1024;
#pragma unroll
        for (int j = 0; j < 4; ++j) { const int col = 4 * c.lane + 256 * j; const f32x4 w = *(const f32x4*)(nw + col); f32x4 h = v[j] * rstd * w;
            if (MODE != 2) { const f32x4 sh = *(const f32x4*)(mrow + col), sc = *(const f32x4*)(mrow + 1024 + col); h = h * (sc + 1.f) + sh; }
            if (MODE == 0) { u32x2 o; o.x = cvt_pk_bf16(h[0], h[1]); o.y = cvt_pk_bf16(h[2], h[3]); *(u32x2*)((bf16_t*)(c.ws + WS_HB) + (size_t)row * 1024 + col) = o; }
            else if (MODE == 1) { u32x2 o; o.x = cvt_pk_bf16(h[0], h[1]); o.y = cvt_pk_bf16(h[2], h[3]); *(u32x2*)((bf16_t*)(c.ws + WS_HF32) + (size_t)row * 1024 + col) = o; }
            else __builtin_nontemporal_store(h, (f32x4*)(c.out + (size_t)row * 1024 + col)); }
    }
}
__device__ __forceinline__ void up8(const u32x4 v, f32x4& a, f32x4& b) {
    a = (f32x4){bf2f(v.x & 0xffffu), bf2f(v.x >> 16), bf2f(v.y & 0xffffu), bf2f(v.y >> 16)}; b = (f32x4){bf2f(v.z & 0xffffu), bf2f(v.z >> 16), bf2f(v.w & 0xffffu), bf2f(v.w >> 16)}; }
__device__ __forceinline__ u32x4 pk8(const f32x4 a, const f32x4 b) { u32x4 o; o.x = cvt_pk_bf16(a[0], a[1]); o.y = cvt_pk_bf16(a[2], a[3]); o.z = cvt_pk_bf16(b[0], b[1]); o.w = cvt_pk_bf16(b[2], b[3]); return o; }
__device__ __forceinline__ void slide16b(const bf16_t* src, int base, int stride, int L, int w, int p0, const bf16_t* hsub, u32x4 (&outp)[16]) {
    const int h2 = w >> 1;
    const int lo0 = max(p0 - h2, 0), hi0 = min(p0 - h2 + w, L);
    f32x4 Sa = {0.f, 0.f, 0.f, 0.f}, Sb = {0.f, 0.f, 0.f, 0.f};
#pragma unroll
    for (int k = 0; k < 16; ++k) { const int q = lo0 + k; f32x4 a, b; up8(*(const u32x4*)(src + (size_t)(base + min(q, L - 1) * stride) * 1024), a, b); if (q < hi0) { Sa = Sa + a; Sb = Sb + b; } }
#pragma unroll
    for (int k = 0; k < 16; ++k) { const int p = p0 + k;
        if (k > 0) { const int qa = p - 1 - h2, qb = p - h2 + w - 1; f32x4 a0, b0, a1, b1;
            up8(*(const u32x4*)(src + (size_t)(base + max(qa, 0) * stride) * 1024), a0, b0); up8(*(const u32x4*)(src + (size_t)(base + min(qb, L - 1) * stride) * 1024), a1, b1);
            if (qa >= 0) { Sa = Sa - a0; Sb = Sb - b0; }
            if (qb < L) { Sa = Sa + a1; Sb = Sb + b1; } }
        const int lo = max(p - h2, 0), hi = min(p - h2 + w, L); const float inv = 1.f / (float)(hi - lo);
        f32x4 ma = Sa * inv, mb = Sb * inv;
        if (hsub) { f32x4 ha, hb; up8(*(const u32x4*)(hsub + (size_t)(base + p * stride) * 1024), ha, hb); ma = ma - ha; mb = mb - hb; }
        outp[k] = pk8(ma, mb); }
}
__device__ __forceinline__ void phase_pool_v(const Ctx& c) {
    const bf16_t* hf = (const bf16_t*)(c.ws + WS_HF32); bf16_t* vs = (bf16_t*)(c.ws + WS_VS);
    const int gt = c.bid * NTHREADS + c.tid, ngt = c.G * NTHREADS;
    for (int i = gt; i < 768 * 128; i += ngt) { const int seg = i >> 7, ch = (i & 127) * 8, w = 2 << (ch >> 8);
        int base, stride, L, p0;
        if (seg < 256) { base = (seg >> 4) * 256; stride = 1; L = 256; p0 = (seg & 15) * 16; }
        else { const int s2 = seg - 256, cc = s2 & 63, rs = (s2 >> 6) & 3, b = s2 >> 8; base = T_CTX + b * 4096 + cc; stride = 64; L = 64; p0 = rs * 16; }
        u32x4 o[16];
        slide16b(hf + ch, base, stride, L, w, p0, nullptr, o);
#pragma unroll
        for (int k = 0; k < 16; ++k) *(u32x4*)(vs + (size_t)(base + (p0 + k) * stride) * 1024 + ch) = o[k]; }
}
__device__ __forceinline__ void phase_pool_h(const Ctx& c) {
    const bf16_t* hf = (const bf16_t*)(c.ws + WS_HF32); const bf16_t* vs = (const bf16_t*)(c.ws + WS_VS); bf16_t* db = (bf16_t*)(c.ws + WS_DBUF);
    const int gt = c.bid * NTHREADS + c.tid, ngt = c.G * NTHREADS;
    for (int i = gt; i < 768 * 128; i += ngt) { const int seg = i >> 7, ch = (i & 127) * 8, g = ch >> 8, w = 2 << g;
        const int t0 = seg * 16;
        u32x4 o[16];
        if (seg < 256) {
            u32x4 mv[16], hv[16];
#pragma unroll
            for (int k = 0; k < 16; ++k) { mv[k] = *(const u32x4*)(vs + (size_t)(t0 + k) * 1024 + ch); hv[k] = *(const u32x4*)(hf + (size_t)(t0 + k) * 1024 + ch); }
#pragma unroll
            for (int k = 0; k < 16; ++k) { f32x4 ma, mb, ha, hb; up8(mv[k], ma, mb); up8(hv[k], ha, hb); o[k] = pk8(ma - ha, mb - hb); }
        } else slide16b(vs + ch, t0 & ~63, 1, 64, w, t0 & 63, hf + ch, o);
#pragma unroll
        for (int k = 0; k < 16; ++k) *(u32x4*)(db + ((size_t)g * T + t0 + k) * 256 + (ch & 255)) = o[k]; }
}
__device__ __forceinline__ void phase_tr(const Ctx& c) {
    LAS unsigned char* scr = c.lds + c.wave * 8448;
    const int lane = c.lane;
#define TR_LOAD(dst8, item) do { const int tb_ = (item) % 192, cb_ = (item) / 192; const bf16_t* src_ = cb_ < 16 ? (const bf16_t*)(c.ws + WS_K) + cb_ * 64 : (const bf16_t*)(c.ws + WS_V) + (cb_ - 16) * 64; const int ld_ = cb_ < 16 ? 1024 : 2048; \
    _Pragma("unroll") for (int i = 0; i < 8; ++i) { const int pc = lane + 64 * i; dst8[i] = *(const u32x4*)(src_ + (size_t)(tb_ * 64 + (pc >> 3)) * ld_ + (pc & 7) * 8); } } while (0)
    u32x4 cur[8], nxt[8];
    if (c.gw < 192 * 48) TR_LOAD(cur, c.gw);
    for (int it = c.gw; it < 192 * 48; it += c.ngw) {
        const int tb = it % 192, cb = it / 192;
        bf16_t* dst = cb < 16 ? (bf16_t*)(c.ws + WS_KT) + (size_t)(cb * 64) * T : (bf16_t*)(c.ws + WS_VT) + (size_t)((cb - 16) * 64) * T;
        const int tok0 = tb * 64;
        const bool more = it + c.ngw < 192 * 48;
        if (more) TR_LOAD(nxt, it + c.ngw);
#pragma unroll
        for (int i = 0; i < 8; ++i) { const int pc = lane + 64 * i, r = pc >> 3, ch = pc & 7; const u32x4 v = cur[i];
            LAS unsigned* d = (LAS unsigned*)(scr + r * 132 + ch * 16); d[0] = v.x; d[1] = v.y; d[2] = v.z; d[3] = v.w; }
        asm volatile("s_waitcnt lgkmcnt(0)" ::: "memory");
        const int tg = lane & 7, cl = lane >> 3;
#pragma unroll
        for (int i = 0; i < 8; ++i) { const int col = cl + 8 * i; const LAS bf16_t* s = (const LAS bf16_t*)(scr + (tg * 8) * 132 + col * 2);
            u32x4 o; o.x = (unsigned)s[0] | ((unsigned)s[66] << 16); o.y = (unsigned)s[2 * 66] | ((unsigned)s[3 * 66] << 16); o.z = (unsigned)s[4 * 66] | ((unsigned)s[5 * 66] << 16); o.w = (unsigned)s[6 * 66] | ((unsigned)s[7 * 66] << 16);
            if (cb < 16) { const int dd = (cb & 3) * 64 + col, j0 = (tok0 & 127) + 8 * tg;
                const int frag = (((((tok0 >> 7) * 4 + (cb >> 2)) * 8 + (dd >> 5)) * 2 + ((dd >> 2) & 1)) * 4 + (j0 >> 5)) * 64 + ((j0 >> 3) & 3) * 16 + ((((dd >> 3) & 3) << 2) | (dd & 3));
                *(u32x4*)((bf16_t*)(c.ws + WS_KT) + (size_t)frag * 8) = o; }
            else *(u32x4*)(dst + (size_t)col * T + tok0 + tg * 8) = o; }
        asm volatile("s_waitcnt lgkmcnt(0)" ::: "memory");
        if (more) {
#pragma unroll
            for (int i = 0; i < 8; ++i) cur[i] = nxt[i]; }
    }
#undef TR_LOAD
}
#define MFMA16(a, b, c) __builtin_amdgcn_mfma_f32_16x16x32_bf16((a), (b), (c), 0, 0, 0)
__device__ __forceinline__ size_t sbuf_index(int slot, int h, int dir) {
    return slot >= 32 ? (size_t)(((slot - 32) * 4 + h) * 2 + dir) : (size_t)(512 + (((slot >> 1) * 4 + h) * 2 + dir));
}
#define R1_LOADA(dst, chunk_tok0) do { _Pragma("unroll") for (int md_ = 0; md_ < 2; ++md_) _Pragma("unroll") for (int ks_ = 0; ks_ < 4; ++ks_) \
    dst[md_][ks_] = *(const bf16x8*)(KTg + ((size_t)((((((chunk_tok0) >> 7) * 4 + h) * 8 + w) * 2 + md_) * 4 + ks_) * 64 + lane) * 8); } while (0)
#define R1_LOADV(dst, chunk_tok0) do { _Pragma("unroll") for (int i_ = 0; i_ < 2; ++i_) { const int pc_ = tid + 512 * i_; \
    dst[i_] = *(const u32x4*)(VTg + (size_t)(h * 512 + 64 * es + (pc_ >> 4)) * T + (chunk_tok0) + (pc_ & 15) * 8); } } while (0)
#define R1_WRITEV(src, buf) do { _Pragma("unroll") for (int i_ = 0; i_ < 2; ++i_) { const int pc_ = tid + 512 * i_, r_ = pc_ >> 4, cj_ = pc_ & 15; const u32x4 v_ = src[i_]; \
    const LAS float* z_ = zl + (dir ? cj_ * 8 : 127 - cj_ * 8); const int zs_ = dir ? 1 : -1; u32x4 o_; \
    o_.x = cvt_pk_bf16(bf2f(v_.x & 0xffffu) * z_[0], bf2f(v_.x >> 16) * z_[zs_]); o_.y = cvt_pk_bf16(bf2f(v_.y & 0xffffu) * z_[2 * zs_], bf2f(v_.y >> 16) * z_[3 * zs_]); \
    o_.z = cvt_pk_bf16(bf2f(v_.z & 0xffffu) * z_[4 * zs_], bf2f(v_.z >> 16) * z_[5 * zs_]); o_.w = cvt_pk_bf16(bf2f(v_.w & 0xffffu) * z_[6 * zs_], bf2f(v_.w >> 16) * z_[7 * zs_]); \
    *(LAS u32x4*)(vT + (buf) * 17408 + r_ * 272 + cj_ * 16) = o_; } } while (0)
#ifndef R1_STORE_REP
#define R1_STORE_REP 1
#endif
#define R1_STEP(ci_, Acur) do { const int ci = (ci_); const int ch = dir ? nch - 1 - ci : ci, slot = slot_base + ch; \
    __syncthreads(); \
    if (lat || ci == 1) { bf16_t* so = sb + sbuf_index(slot, h, dir) * 131072; \
        _Pragma("unroll") for (int ne = 0; ne < 4; ++ne) { u32x4 o; o.x = cvt_pk_bf16(acc[0][ne][0], acc[0][ne][1]); o.y = cvt_pk_bf16(acc[0][ne][2], acc[0][ne][3]); o.z = cvt_pk_bf16(acc[1][ne][0], acc[1][ne][1]); o.w = cvt_pk_bf16(acc[1][ne][2], acc[1][ne][3]); \
            __builtin_nontemporal_store(o, (u32x4*)(so + ((size_t)((es * 8 + w) * 4 + ne) * 64 + lane) * 8)); } } \
    if (ci + 1 < nch) R1_WRITEV(vraw, (ci + 1) & 1); \
    if (ci + 2 < nch) { const int ch2 = dir ? nch - 3 - ci : ci + 2; R1_LOADV(vraw, tok_base + ch2 * 128); } \
    _Pragma("unroll") for (int md = 0; md < 2; ++md) _Pragma("unroll") for (int ne = 0; ne < 4; ++ne) acc[md][ne] = acc[md][ne] * gC; \
    _Pragma("unroll") for (int ks = 0; ks < 4; ++ks) { bf16x8 b[4]; \
        _Pragma("unroll") for (int ne = 0; ne < 4; ++ne) b[ne] = *(const LAS bf16x8*)(vT + (ci & 1) * 17408 + (16 * ne + fr) * 272 + ks * 64 + fq * 16); \
        _Pragma("unroll") for (int md = 0; md < 2; ++md) _Pragma("unroll") for (int ne = 0; ne < 4; ++ne) acc[md][ne] = MFMA16(Acur[md][ks], b[ne], acc[md][ne]); } \
    if (ci + 2 < nch) { const int ch2 = dir ? nch - 3 - ci : ci + 2; R1_LOADA(Acur, tok_base + ch2 * 128); } } while (0)
__device__ __forceinline__ void phase_r1(const Ctx& c, int jr) {
    LAS unsigned char* vT = c.lds;
    LAS float* zl = (LAS float*)(c.lds + 2 * 17408);
    const bf16_t* KTg = (const bf16_t*)(c.ws + WS_KT); const bf16_t* VTg = (const bf16_t*)(c.ws + WS_VT);
    bf16_t* sb = (bf16_t*)(c.ws + WS_SBUF); const float* pwt = (const float*)(c.ws + WS_TAB + TAB_POW);
    const int tid = c.tid, w = c.wave, lane = c.lane, fr = lane & 15, fq = lane >> 4;
    const int nb = c.G, half = nb / 2; const bool lat = c.bid < half;
    const int ntask = lat ? 128 : 1024;
#ifndef R1_CTX_BLOCKS
#define R1_CTX_BLOCKS (nb - half)
#endif
    int bb = lat ? c.bid : c.bid - half; const int nbl = lat ? half : R1_CTX_BLOCKS;
    for (int tq = (lat || bb < nbl) ? bb : ntask; tq < ntask; tq += nbl) {
        int tk = tq;
        if (nbl == 128) { const int x = bb & 7, r = bb >> 3; tk = lat ? ((x * 2 + (r >> 3)) * 8 + (r & 7)) : (((r * 8 + x) * 8) + (tq >> 7)); }
        const int es = tk & 7, dir = (tk >> 3) & 1, h = (tk >> 4) & 3, s = tk >> 6;
        const int nch = lat ? 32 : 2, tok_base = lat ? T_CTX + s * 4096 : s * 256, slot_base = lat ? 32 + s * 32 : s * 2;
        const float* pw = pwt + ((jr * 2 + dir) * 4 + h) * 132; const float gC = pw[128];
        f32x4 acc[2][4];
#pragma unroll
        for (int md = 0; md < 2; ++md)
#pragma unroll
            for (int ne = 0; ne < 4; ++ne) {
                if (lat) { const float* sp = inp(c, I_STATE) + ((size_t)(((s * 2 + jr) * 2 + dir) * 4 + h) * 256 + 32 * w + 8 * fq + 4 * md) * 512 + 64 * es + 16 * ne + fr;
                    acc[md][ne] = (f32x4){sp[0], sp[512], sp[1024], sp[1536]}; }
                else acc[md][ne] = (f32x4){0.f, 0.f, 0.f, 0.f}; }
        bf16x8 A0[2][4], A1[2][4]; u32x4 vraw[2];
        { const int c0 = dir ? nch - 1 : 0, c1 = dir ? nch - 2 : 1;
          __syncthreads();
          if (tid < 132) zl[tid] = pw[tid];
          R1_LOADV(vraw, tok_base + c0 * 128); R1_LOADA(A0, tok_base + c0 * 128);
          __syncthreads();
          R1_WRITEV(vraw, 0);
          R1_LOADV(vraw, tok_base + c1 * 128); R1_LOADA(A1, tok_base + c1 * 128); }
        for (int ci2 = 0; ci2 < nch; ci2 += 2) { R1_STEP(ci2, A0); R1_STEP(ci2 + 1, A1); }
        if (!lat) { float* op = c.out + (size_t)T * 1024 + ((size_t)(((s * 2 + jr) * 2 + dir) * 4 + h) * 256 + 32 * w + 8 * fq) * 512 + 64 * es + fr;
#pragma unroll
            for (int md = 0; md < 2; ++md)
#pragma unroll
                for (int ne = 0; ne < 4; ++ne)
#pragma unroll
                    for (int r = 0; r < 4; ++r) __builtin_nontemporal_store(acc[md][ne][r], op + (size_t)(4 * md + r) * 512 + 16 * ne); }
    }
}
__device__ __forceinline__ void phase_r2(const Ctx& c, int jr) {
    LAS unsigned char* lds = c.lds;
    LAS unsigned char* Pm = lds;
    LAS unsigned char* Ab = lds + 34816;
    LAS unsigned char* Bb = lds + 34816 + 2 * 18432;
    LAS float* pwl = (LAS float*)(lds + 34816 + 2 * 18432 + 2 * 36864);
    const bf16_t* Qg = (const bf16_t*)(c.ws + WS_Q); const bf16_t* Kg = (const bf16_t*)(c.ws + WS_K); const bf16_t* VTg = (const bf16_t*)(c.ws + WS_VT);
    const bf16_t* sb = (const bf16_t*)(c.ws + WS_SBUF); const float* pwt = (const float*)(c.ws + WS_TAB + TAB_POW); bf16_t* Og = (bf16_t*)(c.ws + WS_O);
    const int tid = c.tid, w = c.wave, lane = c.lane, fr = lane & 15, fq = lane >> 4, wi = w >> 2, wj = w & 3;
    for (int task = c.bid; task < 768; task += c.G) {
        const int eh = task & 1, h = (task >> 1) & 3, slot = task >> 3, tok0 = slot * 128;
        const bool lat = slot >= 32; const bool has_f = lat || (slot & 1) == 1, has_b = lat || (slot & 1) == 0;
        const bf16_t* qrow = Qg + (size_t)tok0 * 1024 + h * 256; const bf16_t* krow = Kg + (size_t)tok0 * 1024 + h * 256;
        const bf16_t* vrow = VTg + (size_t)(h * 512 + eh * 256) * T + tok0;
        const bf16_t* sgf = sb + sbuf_index(slot, h, 0) * 131072; const bf16_t* sgb = sb + sbuf_index(slot, h, 1) * 131072;
        u32x4 RA[6], RB[6];
        const int r16 = tid >> 3, c16 = tid & 7, l16 = r16 * 144 + c16 * 16;
        const int ln = tid & 63, wq = tid >> 6;
        const int soff = ((((4 * eh + (wq >> 3)) * 8 + (wq & 1)) * 4 + ((wq >> 1) & 3)) * 64 + ln) * 8;
        const int NT = 6 + (has_f ? 4 : 0) + (has_b ? 4 : 0);
#define R2_TILE(n) ((n) < 6 ? (n) : (has_f ? (n) : (n) + 4))
#define R2_LOAD_P(t_, R) do { _Pragma("unroll") for (int i = 0; i < 2; ++i) { R[i] = *(const u32x4*)(qrow + (size_t)(r16 + 64 * i) * 1024 + (t_) * 64 + c16 * 8); R[2 + i] = *(const u32x4*)(krow + (size_t)(r16 + 64 * i) * 1024 + (t_) * 64 + c16 * 8); } } while (0)
#define R2_LOAD_V(t_, R) do { _Pragma("unroll") for (int i = 0; i < 4; ++i) R[i] = *(const u32x4*)(vrow + (size_t)(r16 + 64 * i) * T + ((t_) - 4) * 64 + c16 * 8); } while (0)
#define R2_LOAD_S(tile, R) do { const int t_ = (tile); const int kd = (t_ - 6) & 3; const bf16_t* sg = (t_ >= 10 ? sgb : sgf) + soff + (size_t)kd * 4096; \
        _Pragma("unroll") for (int i = 0; i < 4; ++i) R[i] = *(const u32x4*)(sg + (size_t)i * 16384); \
        _Pragma("unroll") for (int i = 0; i < 2; ++i) R[4 + i] = *(const u32x4*)(qrow + (size_t)(r16 + 64 * i) * 1024 + kd * 64 + c16 * 8); } while (0)
#define R2_WRITE_P(R, buf) do { LAS unsigned char* A_ = Ab + (buf) * 18432; LAS unsigned char* B_ = Bb + (buf) * 36864; \
        _Pragma("unroll") for (int i = 0; i < 2; ++i) { *(LAS u32x4*)(A_ + l16 + i * 64 * 144) = R[i]; *(LAS u32x4*)(B_ + l16 + i * 64 * 144) = R[2 + i]; } } while (0)
#define R2_WRITE_V(R, buf) do { LAS unsigned char* B_ = Bb + (buf) * 36864; _Pragma("unroll") for (int i = 0; i < 4; ++i) *(LAS u32x4*)(B_ + l16 + i * 64 * 144) = R[i]; } while (0)
#define R2_WRITE_S(tile, R, buf) do { const int t_ = (tile); LAS unsigned char* A_ = Ab + (buf) * 18432; LAS unsigned char* B_ = Bb + (buf) * 36864; \
        _Pragma("unroll") for (int i = 0; i < 4; ++i) *(LAS u32x4*)(B_ + (wq + 8 * i) * 1024 + ln * 16) = R[i]; \
        _Pragma("unroll") for (int i = 0; i < 2; ++i) { const u32x4 v = R[4 + i]; \
            const float xi = t_ >= 10 ? pwl[132 + 128 - (r16 + 64 * i)] : pwl[r16 + 64 * i + 1]; u32x4 o; \
            o.x = cvt_pk_bf16(bf2f(v.x & 0xffffu) * xi, bf2f(v.x >> 16) * xi); o.y = cvt_pk_bf16(bf2f(v.y & 0xffffu) * xi, bf2f(v.y >> 16) * xi); \
            o.z = cvt_pk_bf16(bf2f(v.z & 0xffffu) * xi, bf2f(v.z >> 16) * xi); o.w = cvt_pk_bf16(bf2f(v.w & 0xffffu) * xi, bf2f(v.w >> 16) * xi); \
            *(LAS u32x4*)(A_ + l16 + i * 64 * 144) = o; } } while (0)
#define R2_MMA_P(cur) do { LAS unsigned char* A_ = Ab + (cur) * 18432; LAS unsigned char* B_ = Bb + (cur) * 36864; \
    _Pragma("unroll") for (int kk = 0; kk < 2; ++kk) { bf16x8 a[2], b[4]; \
        _Pragma("unroll") for (int mj = 0; mj < 2; ++mj) a[mj] = *(const LAS bf16x8*)(B_ + (32 * wj + 16 * mj + fr) * 144 + kk * 64 + fq * 16); \
        _Pragma("unroll") for (int ni = 0; ni < 4; ++ni) b[ni] = *(const LAS bf16x8*)(A_ + (64 * wi + 16 * ni + fr) * 144 + kk * 64 + fq * 16); \
        _Pragma("unroll") for (int mj = 0; mj < 2; ++mj) _Pragma("unroll") for (int ni = 0; ni < 4; ++ni) pacc[mj][ni] = MFMA16(a[mj], b[ni], pacc[mj][ni]); } } while (0)
#define R2_MMA_OS(cur, bptr, bstride) do { LAS unsigned char* B_ = Bb + (cur) * 36864; \
    _Pragma("unroll") for (int kk = 0; kk < 2; ++kk) { bf16x8 b[4]; \
        _Pragma("unroll") for (int ni = 0; ni < 4; ++ni) b[ni] = *(const LAS bf16x8*)((bptr) + (64 * wi + 16 * ni + fr) * (bstride) + kk * 64 + fq * 16); \
        _Pragma("unroll") for (int me = 0; me < 4; me += 2) { const bf16x8 a0 = *(const LAS bf16x8*)(B_ + ((4 * wj + me) * 2 + kk) * 1024 + lane * 16), a1 = *(const LAS bf16x8*)(B_ + ((4 * wj + me + 1) * 2 + kk) * 1024 + lane * 16); \
            _Pragma("unroll") for (int ni = 0; ni < 4; ++ni) oacc[me][ni] = MFMA16(a0, b[ni], oacc[me][ni]); \
            _Pragma("unroll") for (int ni = 0; ni < 4; ++ni) oacc[me + 1][ni] = MFMA16(a1, b[ni], oacc[me + 1][ni]); } } } while (0)
#define R2_MMA_O(cur, bptr, bstride) do { LAS unsigned char* B_ = Bb + (cur) * 36864; \
    _Pragma("unroll") for (int kk = 0; kk < 2; ++kk) { bf16x8 b[4]; \
        _Pragma("unroll") for (int ni = 0; ni < 4; ++ni) b[ni] = *(const LAS bf16x8*)((bptr) + (64 * wi + 16 * ni + fr) * (bstride) + kk * 64 + fq * 16); \
        _Pragma("unroll") for (int me = 0; me < 4; me += 2) { const bf16x8 a0 = *(const LAS bf16x8*)(B_ + (64 * wj + 16 * me + fr) * 144 + kk * 64 + fq * 16), a1 = *(const LAS bf16x8*)(B_ + (64 * wj + 16 * me + 16 + fr) * 144 + kk * 64 + fq * 16); \
            _Pragma("unroll") for (int ni = 0; ni < 4; ++ni) oacc[me][ni] = MFMA16(a0, b[ni], oacc[me][ni]); \
            _Pragma("unroll") for (int ni = 0; ni < 4; ++ni) oacc[me + 1][ni] = MFMA16(a1, b[ni], oacc[me + 1][ni]); } } } while (0)
        __syncthreads();
        { int t2 = tid; asm volatile("" : "+v"(t2));
          if (t2 < 264) { const int dd = t2 >= 132 ? 1 : 0, n = t2 - dd * 132; pwl[t2] = pwt[((jr * 2 + dd) * 4 + h) * 132 + n]; } }
        R2_LOAD_P(0, RA); R2_LOAD_P(1, RB); R2_WRITE_P(RA, 0); R2_LOAD_P(2, RA);
        __syncthreads();
        {
            f32x4 pacc[2][4];
#pragma unroll
            for (int a = 0; a < 2; ++a)
#pragma unroll
                for (int b = 0; b < 4; ++b) pacc[a][b] = (f32x4){0.f, 0.f, 0.f, 0.f};
            R2_WRITE_P(RB, 1); R2_LOAD_P(3, RB); R2_MMA_P(0); __syncthreads();
            R2_WRITE_P(RA, 0); R2_LOAD_V(4, RA); R2_MMA_P(1); __syncthreads();
            R2_WRITE_P(RB, 1); R2_LOAD_V(5, RB); R2_MMA_P(0); __syncthreads();
            R2_WRITE_V(RA, 0); if (NT > 6) R2_LOAD_S(R2_TILE(6), RA); R2_MMA_P(1);
#pragma unroll
            for (int mj = 0; mj < 2; ++mj)
#pragma unroll
                for (int ni = 0; ni < 4; ++ni) { const int i = 64 * wi + 16 * ni + fr, j0 = 32 * wj + 16 * mj + 4 * fq; float v[4];
#pragma unroll
                    for (int r = 0; r < 4; ++r) { const int df = i - (j0 + r); v[r] = pacc[mj][ni][r] * (df >= 0 ? pwl[df] : pwl[132 - df]); }
                    u32x2 o; o.x = cvt_pk_bf16(v[0], v[1]); o.y = cvt_pk_bf16(v[2], v[3]);
                    *(LAS u32x2*)(Pm + i * 272 + j0 * 2) = o; }
            __syncthreads();
        }
        f32x4 oacc[4][4];
#pragma unroll
        for (int a = 0; a < 4; ++a)
#pragma unroll
            for (int b = 0; b < 4; ++b) oacc[a][b] = (f32x4){0.f, 0.f, 0.f, 0.f};
        R2_WRITE_V(RB, 1); if (NT > 7) R2_LOAD_S(R2_TILE(7), RB); R2_MMA_O(0, Pm, 272); __syncthreads();
        if (NT > 6) R2_WRITE_S(R2_TILE(6), RA, 0); if (NT > 8) R2_LOAD_S(R2_TILE(8), RA); R2_MMA_O(1, Pm + 128, 272); __syncthreads();
        for (int n = 6; n < NT; n += 2) {
            if (n + 1 < NT) R2_WRITE_S(R2_TILE(n + 1), RB, 1); if (n + 3 < NT) R2_LOAD_S(R2_TILE(n + 3), RB); R2_MMA_OS(0, Ab, 144); __syncthreads();
            if (n + 2 < NT) R2_WRITE_S(R2_TILE(n + 2), RA, 0); if (n + 4 < NT) R2_LOAD_S(R2_TILE(n + 4), RA); R2_MMA_OS(1, Ab + 18432, 144); __syncthreads();
        }
        {
            int t3 = tid; asm volatile("" : "+v"(t3));
            LAS float* st = (LAS float*)Pm;
            LAS float* st2 = (LAS float*)(Pm + 4096);
            unsigned long long* gstats = (unsigned long long*)(c.ws + WS_MODP); unsigned* gflag = (unsigned*)(c.ws + WS_BAR + 16384);
            const unsigned epoch = (unsigned)jr + 1u;
#pragma unroll
            for (int ni = 0; ni < 4; ++ni) { float s1 = 0.f, s2 = 0.f;
#pragma unroll
                for (int me = 0; me < 4; ++me)
#pragma unroll
                    for (int r = 0; r < 4; ++r) { const float v = oacc[me][ni][r]; s1 += v; s2 += v * v; }
                s1 += __shfl_xor(s1, 16); s1 += __shfl_xor(s1, 32); s2 += __shfl_xor(s2, 16); s2 += __shfl_xor(s2, 32);
                if (fq == 0) { const int i = 64 * wi + 16 * ni + fr; st[(i * 4 + wj) * 2] = s1; st[(i * 4 + wj) * 2 + 1] = s2; } }
            __syncthreads();
            u32x2 gq[4][4]; f32x4 gnv[4];
            const bf16_t* Gg = (const bf16_t*)(c.ws + WS_G); const float* gnw = inp(c, I_GNW) + (jr * 4 + h) * 512 + eh * 256 + 64 * wj + 4 * fq;
#pragma unroll
            for (int me = 0; me < 4; ++me) { gnv[me] = *(const f32x4*)(gnw + 16 * me);
#pragma unroll
                for (int ni = 0; ni < 4; ++ni) gq[me][ni] = *(const u32x2*)(Gg + (size_t)(tok0 + 64 * wi + 16 * ni + fr) * 2048 + h * 512 + eh * 256 + 64 * wj + 16 * me + 4 * fq); }
            float p1 = 0.f, p2 = 0.f;
            if (t3 < 128) {
#pragma unroll
                for (int q = 0; q < 4; ++q) { p1 += st[(t3 * 4 + q) * 2]; p2 += st[(t3 * 4 + q) * 2 + 1]; }
                const unsigned long long pk = (unsigned long long)__builtin_bit_cast(unsigned, p1) | ((unsigned long long)__builtin_bit_cast(unsigned, p2) << 32);
                __hip_atomic_store(gstats + (size_t)task * 128 + t3, pk, __ATOMIC_RELAXED, __HIP_MEMORY_SCOPE_AGENT); }
            asm volatile("s_waitcnt vmcnt(0)" ::: "memory");
            __syncthreads();
            if (t3 == 0) {
                __hip_atomic_store(gflag + task, epoch, __ATOMIC_RELAXED, __HIP_MEMORY_SCOPE_AGENT);
                unsigned sp = 0;
                while (__hip_atomic_load(gflag + (task ^ 1), __ATOMIC_RELAXED, __HIP_MEMORY_SCOPE_AGENT) != epoch) { __builtin_amdgcn_s_sleep(2); if (++sp > (1u << 20)) break; }
                __builtin_amdgcn_fence(__ATOMIC_ACQUIRE, "agent");
                asm volatile("s_waitcnt vmcnt(0)" ::: "memory"); }
            __syncthreads();
            if (t3 < 128) {
                const unsigned long long q = __hip_atomic_load(gstats + (size_t)(task ^ 1) * 128 + t3, __ATOMIC_RELAXED, __HIP_MEMORY_SCOPE_AGENT);
                const float S1 = p1 + __builtin_bit_cast(float, (unsigned)(q & 0xffffffffull)), S2 = p2 + __builtin_bit_cast(float, (unsigned)(q >> 32));
                const float mu = S1 * (1.f / 512.f), var = fmaxf(S2 * (1.f / 512.f) - mu * mu, 0.f);
                st2[t3 * 2] = mu; st2[t3 * 2 + 1] = rsqrtf(var + GN_EPS); }
            __syncthreads();
            bf16_t* Ag = (bf16_t*)(c.ws + WS_A);
#pragma unroll
            for (int ni = 0; ni < 4; ++ni) { const int i = 64 * wi + 16 * ni + fr; const float mu = st2[i * 2], rs = st2[i * 2 + 1];
#pragma unroll
                for (int me = 0; me < 4; ++me) { const u32x2 gb = gq[me][ni];
                    const float g0 = bf2f(gb.x & 0xffffu), g1 = bf2f(gb.x >> 16), g2 = bf2f(gb.y & 0xffffu), g3 = bf2f(gb.y >> 16);
                    const f32x4 o = (oacc[me][ni] - mu) * rs * gnv[me];
                    u32x2 w; w.x = cvt_pk_bf16(silu_f(g0) * o[0], silu_f(g1) * o[1]); w.y = cvt_pk_bf16(silu_f(g2) * o[2], silu_f(g3) * o[3]);
                    *(u32x2*)(Ag + (size_t)(tok0 + i) * 2048 + h * 512 + eh * 256 + 64 * wj + 16 * me + 4 * fq) = w; } }
        }
    }
}
__device__ __forceinline__ void phase_gate(const Ctx& c, int jr) {
    const bf16_t* Og = (const bf16_t*)(c.ws + WS_O); const bf16_t* Gg = (const bf16_t*)(c.ws + WS_G); bf16_t* Ag = (bf16_t*)(c.ws + WS_A);
    const float* gnw = inp(c, I_GNW) + jr * 4 * 512;
    for (int it0 = c.gw; it0 < T * 4; it0 += 4 * c.ngw) {
        u32x2 ob[4][2], gb[4][2];
#pragma unroll
        for (int k = 0; k < 4; ++k) { const int it = min(it0 + k * c.ngw, T * 4 - 1); const size_t base = (size_t)(it >> 2) * 2048 + (it & 3) * 512;
#pragma unroll
            for (int j = 0; j < 2; ++j) { ob[k][j] = *(const u32x2*)(Og + base + 4 * c.lane + 256 * j); gb[k][j] = *(const u32x2*)(Gg + base + 4 * c.lane + 256 * j); } }
#pragma unroll
        for (int k = 0; k < 4; ++k) { const int it = it0 + k * c.ngw; if (it < T * 4) { const int h = it & 3; const size_t base = (size_t)(it >> 2) * 2048 + h * 512;
            f32x4 v[2]; float s = 0.f;
#pragma unroll
            for (int j = 0; j < 2; ++j) { v[j] = (f32x4){bf2f(ob[k][j].x & 0xffffu), bf2f(ob[k][j].x >> 16), bf2f(ob[k][j].y & 0xffffu), bf2f(ob[k][j].y >> 16)}; s += (v[j][0] + v[j][1]) + (v[j][2] + v[j][3]); }
            const float mu = wave_sum(s) * (1.f / 512.f); float q = 0.f;
#pragma unroll
            for (int j = 0; j < 2; ++j) { v[j] = v[j] - mu; q += (v[j][0] * v[j][0] + v[j][1] * v[j][1]) + (v[j][2] * v[j][2] + v[j][3] * v[j][3]); }
            const float rstd = rsqrtf(wave_sum(q) * (1.f / 512.f) + GN_EPS);
#pragma unroll
            for (int j = 0; j < 2; ++j) { const int col = 4 * c.lane + 256 * j; const f32x4 gw = *(const f32x4*)(gnw + h * 512 + col);
                const float g0 = bf2f(gb[k][j].x & 0xffffu), g1 = bf2f(gb[k][j].x >> 16), g2 = bf2f(gb[k][j].y & 0xffffu), g3 = bf2f(gb[k][j].y >> 16);
                const f32x4 o = v[j] * rstd * gw;
                u32x2 w; w.x = cvt_pk_bf16(silu_f(g0) * o[0], silu_f(g1) * o[1]); w.y = cvt_pk_bf16(silu_f(g2) * o[2], silu_f(g3) * o[3]);
                *(u32x2*)(Ag + base + col) = w; } } }
    }
}

#ifndef MULTI_LAUNCH
#define MULTI_LAUNCH 0
#endif
#define PH_ON (ph >= p.ph_lo && ph < p.ph_hi)
#define FRESH const Ctx c = fresh_ctx(&p, lds, bar.w0); unsigned char* const ws = c.ws; const int G = c.G; const float* const mod = (const float*)(ws + WS_MOD); (void)G; (void)mod
#ifndef SYNC_REP
#define SYNC_REP 1
#endif
#ifndef REP_R1
#define REP_R1 1
#endif
#ifndef REP_R2
#define REP_R2 1
#endif
#ifndef REP_LIGHT
#define REP_LIGHT 1
#endif
#ifndef REP_POOL
#define REP_POOL 1
#endif
#ifndef REP_NORM
#define REP_NORM 1
#endif
#ifndef REP_TR
#define REP_TR 1
#endif
#ifndef REP_GATE
#define REP_GATE 1
#endif
#ifndef REP_P0
#define REP_P0 1
#endif
#ifndef REP_P0C
#define REP_P0C 1
#endif
#ifndef REP_GEMM_IN
#define REP_GEMM_IN 1
#endif
#ifndef REP_GEMM_UP
#define REP_GEMM_UP 1
#endif
#ifndef REP_GEMM_DOWN
#define REP_GEMM_DOWN 1
#endif
#ifndef REP_GEMM
#define REP_GEMM 1
#endif
#define PH_END do { ++ph; if (ph > p.ph_lo && ph < p.ph_hi) { for (int r_ = 0; r_ < SYNC_REP; ++r_) xcd_barrier(bar); } } while (0)
template <class Sched> __device__ __forceinline__ void stage_rstd_bias(const Ctx& c, const Sched& S, const float* rowss, const float* bias, int ldb) {
    LAS float* tab = (LAS float*)(c.lds + 132 * 1024);
    pg8::Unit u;
    for (int i = 0; i < 8 && S.next(i, u); ++i) {
        if (c.tid < 256) { const f32x4* rp = (const f32x4*)(rowss + (size_t)(u.pm * 256 + c.tid) * 16); const f32x4 a = rp[0] + rp[1] + rp[2] + rp[3];
            tab[i * 512 + c.tid] = rsqrtf(((a[0] + a[1]) + (a[2] + a[3])) * (1.f / 1024.f) + NORM_EPS); }
        else { const int cvv = u.pm < 16 ? 0 : (u.pm < 32 ? 1 : 2); tab[i * 512 + c.tid] = bias[(size_t)cvv * ldb + u.pn * 256 + (c.tid - 256)]; }
    }
    __syncthreads();
}
template <class Sched> __device__ __forceinline__ void stage_res_vectors(const Ctx& c, const Sched& S, const float* gate, int nh, const float* nw, const float* sc) {
    LAS float* tab = (LAS float*)(c.lds + 132 * 1024);
    pg8::Unit u;
    for (int i = 0; i < 2 && S.next(i, u); ++i)
        for (int idx = c.tid; idx < 1536; idx += NTHREADS) { const int which = idx >= 768 ? 1 : 0, r = idx - which * 768, cvv = r >> 8, col = u.pn * 256 + (r & 255);
            tab[i * 1536 + idx] = which == 0 ? gate[(size_t)cvv * NMOD + col] : (nh ? nw[col] * (1.f + sc[(size_t)cvv * NMOD + col]) : 0.f); }
    __syncthreads();
}
template <int l> __device__ __forceinline__ void run_layer(const Params& p, LAS unsigned char* const lds, const XcdBarrier& bar, int& ph) {
        const int j2 = l >> 1;
        if ((l & 1) == 0) {
            if (PH_ON) { for (int r_ = 0; r_ < REP_NORM; ++r_) { FRESH; if (l == 0) bias_finalize(c); phase_norm<1>(c, l, 0, l == 0); } }
            PH_END;
            if (PH_ON) { for (int r_ = 0; r_ < REP_POOL; ++r_) { FRESH; phase_pool_v(c); } }
            PH_END;
            if (PH_ON) { for (int r_ = 0; r_ < REP_POOL; ++r_) { FRESH; phase_pool_h(c); } }
            PH_END;
            if (PH_ON) { FRESH;
                pg8::Gemm g{(const bf16_t*)(ws + WS_DBUF), (const bf16_t*)(ws + WS_PWT) + (size_t)j2 * 262144, 4 * T, 1024, 256};
                pg8::PoolOrder S{G, c.bid};
                pg8::EpiPool E{(float*)(ws + WS_X), inp(c, I_XP), inp(c, I_XS), l == 0 ? 1 : 0, mod + (size_t)(l * 3) * NMOD + 2 * 1024, inp(c, I_PB) + j2 * 1024, inp(c, I_PS) + j2 * 1024,
                                inp(c, I_NMLP) + l * 1024, mod + (size_t)(l * 3) * NMOD + 4 * 1024, (bf16_t*)(ws + WS_HB), (float*)(ws + WS_ROWSS)};
                pg8::gemm_phase<pg8::EpiPool, pg8::PoolOrder, true, true>(c.lds, g, S, E, c.tid);
            }
            PH_END;
        } else {
            if (PH_ON) { FRESH;
                pg8::Gemm g{(const bf16_t*)(ws + WS_HB), (const bf16_t*)(ws + WS_WINT) + (size_t)j2 * RIN * 1024, T, RIN, 1024};
                pg8::EpiInproj E{(bf16_t*)(ws + WS_Q), (bf16_t*)(ws + WS_K), (bf16_t*)(ws + WS_V), (bf16_t*)(ws + WS_G), (const float*)(ws + WS_TAB + TAB_ROPE), (const LAS float*)(c.lds + 132 * 1024), 0};
                if (G == 256) { pg8::InprojOrder S; S.init(G, c.bid);
                    stage_rstd_bias(c, S, (const float*)(ws + WS_ROWSS), (const float*)(ws + WS_BIASI) + (size_t)j2 * 3 * RIN, RIN);
                    pg8::gemm_phase<pg8::EpiInproj, pg8::InprojOrder, true, true>(c.lds, g, S, E, c.tid); }
                else { pg8::StaticOrder S; S.init(T, RIN, G, c.bid);
                    stage_rstd_bias(c, S, (const float*)(ws + WS_ROWSS), (const float*)(ws + WS_BIASI) + (size_t)j2 * 3 * RIN, RIN);
                    pg8::gemm_phase<pg8::EpiInproj, pg8::StaticOrder, true, true>(c.lds, g, S, E, c.tid); }
            }
            PH_END;
            if (PH_ON) { for (int r_ = 0; r_ < REP_TR; ++r_) { FRESH; phase_tr(c); } }
            PH_END;
            if (PH_ON) { for (int r_ = 0; r_ < REP_R1; ++r_) { FRESH; phase_r1(c, j2); }
                { FRESH;
                  if (G == 256 && c.bid >= 128) { const int idx = c.bid - 128;
                    __syncthreads();
                    pg8::Gemm g{(const bf16_t*)(ws + WS_HB), (const bf16_t*)(ws + WS_WINT) + (size_t)j2 * RIN * 1024, T, RIN, 1024};
                    pg8::SingleOrder S{idx & 15, 16 + (idx >> 4)};
                    pg8::EpiInproj E{(bf16_t*)(ws + WS_Q), (bf16_t*)(ws + WS_K), (bf16_t*)(ws + WS_V), (bf16_t*)(ws + WS_G), (const float*)(ws + WS_TAB + TAB_ROPE), (const LAS float*)(c.lds + 132 * 1024), 0};
                    stage_rstd_bias(c, S, (const float*)(ws + WS_ROWSS), (const float*)(ws + WS_BIASI) + (size_t)j2 * 3 * RIN, RIN);
                    pg8::gemm_phase<pg8::EpiInproj, pg8::SingleOrder, true, true>(c.lds, g, S, E, c.tid); } } }
            PH_END;
            if (PH_ON) { for (int r_ = 0; r_ < REP_R2; ++r_) { FRESH; phase_r2(c, j2); } }
            PH_END;
            if (PH_ON) { FRESH;
                pg8::Gemm g{(const bf16_t*)(ws + WS_A), (const bf16_t*)(ws + WS_WOUTT) + (size_t)j2 * 1024 * HV, T, 1024, HV};
                pg8::StaticOrder S; S.init(T, 1024, G, c.bid); S.nM = T / 192; S.nwg = S.nM * S.nN;
                pg8::EpiRes192 E{(float*)(ws + WS_X), 1, (bf16_t*)(ws + WS_HB), (float*)(ws + WS_ROWSS), (const LAS float*)(c.lds + 132 * 1024), 0};
                stage_res_vectors(c, S, mod + (size_t)(l * 3) * NMOD + 2 * 1024, 1, inp(c, I_NMLP) + l * 1024, mod + (size_t)(l * 3) * NMOD + 4 * 1024);
                pg8::gemm_phase<pg8::EpiRes192, pg8::StaticOrder, true, true, 3>(c.lds, g, S, E, c.tid);
            }
            PH_END;
        }
        if (PH_ON) { FRESH;
            pg8::Gemm g{(const bf16_t*)(ws + WS_HB), (const bf16_t*)(ws + WS_W1T) + (size_t)l * 4096 * 1024, T, FF, 1024};
            pg8::StaticOrder S; S.init(T, FF, G, c.bid);
            pg8::EpiUp E{(bf16_t*)(ws + WS_H), (const LAS float*)(c.lds + 132 * 1024), 0};
            stage_rstd_bias(c, S, (const float*)(ws + WS_ROWSS), (const float*)(ws + WS_BIASU) + (size_t)l * 3 * 4096, 4096);
            for (int r_ = 0; r_ < REP_GEMM_UP; ++r_) { E.ord = 0; pg8::gemm_phase<pg8::EpiUp, pg8::StaticOrder, true, true>(c.lds, g, S, E, c.tid); }
        }
        PH_END;
        if (PH_ON) { FRESH;
            pg8::Gemm g{(const bf16_t*)(ws + WS_H), (const bf16_t*)(ws + WS_W2T) + (size_t)l * 1024 * 4096, T, 1024, FF};
            pg8::StaticOrder S; S.init(T, 1024, G, c.bid); S.nM = T / 192; S.nwg = S.nM * S.nN;
            pg8::EpiRes192 E{(float*)(ws + WS_X), (l & 1) == 0 ? 1 : 0, (bf16_t*)(ws + WS_HB), (float*)(ws + WS_ROWSS), (const LAS float*)(c.lds + 132 * 1024), 0};
            stage_res_vectors(c, S, mod + (size_t)(l * 3) * NMOD + 5 * 1024, (l & 1) == 0 ? 1 : 0, inp(c, I_NMIX) + ((l + 1) & 3) * 1024, mod + (size_t)(((l + 1) & 3) * 3) * NMOD + 1 * 1024);
            for (int r_ = 1; r_ < REP_GEMM_DOWN; ++r_) { pg8::EpiRes192 E2{(float*)(ws + WS_O), 0, (bf16_t*)(ws + WS_HB), (float*)(ws + WS_ROWSS), (const LAS float*)(c.lds + 132 * 1024), 0}; pg8::gemm_phase<pg8::EpiRes192, pg8::StaticOrder, true, true, 3>(c.lds, g, S, E2, c.tid); }
            if (l == 3 && G == 256) {
                pg8::EpiFinal192 EF{(const float*)(ws + WS_X), c.out, inp(c, I_FNW), (const LAS float*)(c.lds + 132 * 1024), (unsigned*)(ws + WS_MODP + MiB), (unsigned*)(ws + WS_BAR + 16384 + 3072)};
                pg8::gemm_phase<pg8::EpiFinal192, pg8::StaticOrder, false, true, 3>(c.lds, g, S, EF, c.tid);
            } else {
            pg8::gemm_phase<pg8::EpiRes192, pg8::StaticOrder, true, true, 3>(c.lds, g, S, E, c.tid);
            if (l == 3) { xcd_barrier(bar); phase_norm<2>(c, 0, 0, 0); } }
        }
        if (l != 3) PH_END;
    }
constexpr int N_PHASES = 3 + 2 * 6 + 2 * 7;
__global__ void __launch_bounds__(NTHREADS) fwd_megakernel(Params p) {
    extern __shared__ __attribute__((aligned(16))) unsigned char lds_raw[];
    cg::grid_group grid = cg::this_grid();
    LAS unsigned char* const lds = (LAS unsigned char*)lds_raw;
    if (p.ph_hi < 0) grid.sync();
    volatile LAS unsigned* const bst = (volatile LAS unsigned*)(lds + LDS_BAR_OFF);
    if (threadIdx.x < 4) bst[threadIdx.x] = 0u;
    __syncthreads();
    XcdBarrier bar = xcd_barrier_post((unsigned*)(p.ws + WS_BAR), bst);
    bar.w0 = __builtin_amdgcn_readfirstlane((int)threadIdx.x >> 6);
    int ph = 0;
    if (PH_ON) { for (int r_ = 0; r_ < REP_P0; ++r_) { FRESH; phase_p0(c); } }
    PH_END;
    if (PH_ON) { FRESH; phase_p0b(c); }
    PH_END;
    if (PH_ON) { for (int r_ = 0; r_ < REP_P0C; ++r_) { FRESH; phase_p0c(c); } }
    PH_END;
    run_layer<0>(p, lds, bar, ph); run_layer<1>(p, lds, bar, ph); run_layer<2>(p, lds, bar, ph); run_layer<3>(p, lds, bar, ph);
}

extern "C" void kernel_launch(void* const* d_in, const int* in_sizes, int n_in, void* d_out, int out_size, void* d_ws, size_t ws_size, hipStream_t stream) {
    static int grid = 0;
    if (grid == 0) {
        if (n_in != 19 || ws_size < WS_END) { fprintf(stderr, "kernel_launch: unexpected n_in %d / ws_size %zu\n", n_in, ws_size); grid = -1; return; }
        int dev = 0, cus = 0, per_cu = 0;
        hipGetDevice(&dev); hipDeviceGetAttribute(&cus, hipDeviceAttributeMultiprocessorCount, dev);
        if (hipFuncSetAttribute((const void*)fwd_megakernel, hipFuncAttributeMaxDynamicSharedMemorySize, LDS_BYTES) != hipSuccess) { fprintf(stderr, "kernel_launch: hipFuncSetAttribute failed\n"); grid = -1; return; }
        if (hipOccupancyMaxActiveBlocksPerMultiprocessor(&per_cu, (const void*)fwd_megakernel, NTHREADS, LDS_BYTES) != hipSuccess || per_cu < 1) { fprintf(stderr, "kernel_launch: occupancy query says %d\n", per_cu); per_cu = 1; }
        (void)hipGetLastError();
        grid = cus;
    }
    if (grid < 0) return;
    if (hipMemsetAsync((char*)d_ws + WS_BAR, 0, 16384 + 4096, stream) != hipSuccess) { fprintf(stderr, "kernel_launch: memset of barrier words failed\n"); return; }
    Params p{};
    for (int i = 0; i < 19; ++i) p.in[i] = (const float*)d_in[i];
    p.out = (float*)d_out; p.ws = (unsigned char*)d_ws;
#if MULTI_LAUNCH
    for (int k = 0; k < N_PHASES; ++k) { p.ph_lo = k; p.ph_hi = k + 1; hipLaunchKernelGGL(fwd_megakernel, dim3(grid), dim3(NTHREADS), LDS_BYTES, stream, p); }
#else
    p.ph_lo = 0; p.ph_hi = N_PHASES;
    void* args[] = {&p};
    hipError_t e = hipLaunchCooperativeKernel((const void*)fwd_megakernel, dim3(grid), dim3(NTHREADS), args, LDS_BYTES, stream);
    if (e != hipSuccess) fprintf(stderr, "kernel_launch: cooperative launch failed: %s (grid %d)\n", hipGetErrorString(e), grid);
#endif
}
```

```cpp
#include <hip/hip_runtime.h>
#include <hip/hip_cooperative_groups.h>
#include <cstdio>
#include <cstdint>
namespace cg = cooperative_groups;

#define LAS __attribute__((address_space(3)))
typedef unsigned short bf16_t;
typedef short bf16x8 __attribute__((ext_vector_type(8)));
typedef float f32x4 __attribute__((ext_vector_type(4)));
typedef float f32x2 __attribute__((ext_vector_type(2)));
typedef unsigned u32x4 __attribute__((ext_vector_type(4)));
typedef unsigned u32x2 __attribute__((ext_vector_type(2)));

constexpr int D = 1024, FF = 4096, T_CTX = 4096, T = 12288, RIN = 6144, HV = 2048, NMOD = 6144;
constexpr float NORM_EPS = 1e-6f, GN_EPS = 1e-5f;
constexpr int NWAVES = 8, NTHREADS = 512;
constexpr size_t MiB = 1u << 20;
constexpr size_t WS_W1T = 0, WS_W2T = 32 * MiB, WS_WINT = 64 * MiB, WS_WOUTT = 88 * MiB, WS_PWT = 96 * MiB, WS_MODP = 97 * MiB, WS_MOD = 102 * MiB,
                 WS_TAB = 103 * MiB, WS_X = 104 * MiB, WS_HB = 152 * MiB, WS_Q = 176 * MiB, WS_K = 200 * MiB, WS_V = 224 * MiB, WS_G = 272 * MiB,
                 WS_O = 320 * MiB, WS_VT = 416 * MiB, WS_SBUF = 464 * MiB, WS_END = 624 * MiB;
constexpr size_t WS_KT = WS_O + 48 * MiB  , WS_DBUF = WS_G, WS_A = WS_O, WS_HF32 = WS_O, WS_VS = WS_O + 48 * MiB, WS_H = WS_SBUF;
constexpr size_t WS_BAR = WS_MOD + 512 * 1024;
constexpr size_t WS_ROWSS = WS_TAB + 128 * 1024;
constexpr size_t WS_BIASP = WS_VS, WS_BIASU = WS_MOD + 528 * 1024, WS_BIASI = WS_BIASU + 4 * 3 * 4096 * 4;
constexpr size_t TAB_ROPE = 0, TAB_POW = 65536;
constexpr int LDS_BYTES = 151 * 1024, LDS_BAR_OFF = 150 * 1024;

struct Params { const float* in[19]; float* out; unsigned char* ws; int ph_lo, ph_hi; };
enum { I_XP = 0, I_XS, I_STATE, I_C, I_CCTX, I_WADA, I_BADA, I_NMIX, I_NMLP, I_PW, I_PB, I_PS, I_WIN, I_DECAY, I_GNW, I_WOUT, I_W1, I_W2, I_FNW };

__device__ __forceinline__ int tid_from_wave(int wave0) { return wave0 * 64 + (int)__builtin_amdgcn_mbcnt_hi(~0u, __builtin_amdgcn_mbcnt_lo(~0u, 0u)); }
__device__ __forceinline__ float bf2f(unsigned h) { return __builtin_bit_cast(float, h << 16); }
__device__ __forceinline__ unsigned cvt_pk_bf16(float lo, float hi) { unsigned r; asm volatile("v_cvt_pk_bf16_f32 %0, %1, %2" : "=v"(r) : "v"(lo), "v"(hi)); return r; }
__device__ __forceinline__ float wave_sum(float v) {
#pragma unroll
    for (int o = 1; o < 64; o <<= 1) v += __shfl_xor(v, o);
    return v;
}
__device__ __forceinline__ float silu_f(float v) { return v / (1.f + __expf(-v)); }
__device__ __forceinline__ int perm8(int L) { return (L & ~31) | (((L >> 2) & 1) << 4) | (((L >> 3) & 3) << 2) | (L & 3); }
__device__ __forceinline__ int permrope(int L) { return (L & ~127) | (((L >> 4) & 3) << 5) | (((L >> 6) & 1) << 4) | (L & 15); }
__device__ __forceinline__ int cv_of_row(int row) { return row < T_CTX ? 0 : 1 + ((row - T_CTX) >> 12); }

namespace pg8 {
#define PG8_LAS __attribute__((address_space(3)))
typedef unsigned short bf16_t;
typedef short bf16x8 __attribute__((ext_vector_type(8)));
typedef float f32x4 __attribute__((ext_vector_type(4)));
typedef unsigned u32x4 __attribute__((ext_vector_type(4)));
constexpr int BM = 256, BK = 64, HALF = 128, HTB = HALF * BK * 2  , STAGE_BYTES = 8 * HTB, NXCD = 8, WGM = 8;

__host__ __device__ __forceinline__ int lds_byte(int r, int c) { const int st = (r >> 4) * 2 + (c >> 5), rr = r & 15, cc = c & 31, ob = rr * 64 + cc * 2; return st * 1024 + (ob ^ (((ob >> 9) & 1) << 5)); }
__host__ __device__ __forceinline__ void stage_rc(int b, int& R, int& C) { const int st = b / 1024, sb = b % 1024, swz = sb ^ (((sb >> 9) & 1) << 5); R = (st >> 1) * 16 + swz / 64; C = (st & 1) * 32 + (swz % 64) / 2; }
__host__ __device__ __forceinline__ int perm32(int rho) { const int n = rho >> 4, i = rho & 15; return 8 * (i >> 2) + 4 * n + (i & 3); }

struct Unit { int pm, pn; };
struct Gemm { const bf16_t* A; const bf16_t* Bt; int M, N, K; };

struct StaticOrder {
    int nM, nN, nwg, G, c;
    __host__ __device__ void init(int M, int N, int G_, int c_) { nM = M / BM; nN = N / BM; nwg = nM * nN; G = G_; c = c_; }
    __host__ __device__ bool next(int i, Unit& u) const {
        const long L = (long)i * G + c; if (L >= nwg) return false;
        int wgid = (int)L; { const int q = nwg / NXCD, r = nwg % NXCD, xcd = wgid % NXCD, off = wgid / NXCD; wgid = (xcd < r ? xcd * (q + 1) : r * (q + 1) + (xcd - r) * q) + off; }
        const int nig = WGM * nN, gid = wgid / nig, fm = gid * WGM, gsz = (nM - fm) < WGM ? (nM - fm) : WGM;
        u.pm = fm + ((wgid % nig) % gsz); u.pn = (wgid % nig) / gsz; return true;
    }
    __device__ __forceinline__ void a_ready(const Unit&) const {}
    __device__ __forceinline__ void done(const Unit&) const {}
};

__device__ __forceinline__ unsigned cvt_pk_bf16(float lo, float hi) { unsigned r; asm volatile("v_cvt_pk_bf16_f32 %0, %1, %2" : "=v"(r) : "v"(lo), "v"(hi)); return r; }

struct PoolOrder {
    int G, c;
    __device__ bool next(int i, Unit& u) const { const long L = (long)i * G + c; if (L >= 192) return false; u.pm = (int)L; u.pn = (int)L / 48; return true; }
    __device__ __forceinline__ void a_ready(const Unit&) const {}
    __device__ __forceinline__ void done(const Unit&) const {}
};
struct InprojOrder {
    StaticOrder L, C; int G, c;
    __device__ void init(int G_, int c_) { G = G_; c = c_; L.init(8192, 6144, G_, c_); C.init(4096, 4096, G_, c_); }
    __device__ bool next(int i, Unit& u) const { const long id = (long)i * G + c; if (id >= 1024) return false;
        if (id < 768) { StaticOrder t = L; t.c = (int)(id % G); if (!t.next((int)(id / G), u)) return false; u.pm += 16; return true; }
        const long k = id - 768; StaticOrder t = C; t.c = (int)(k % G); return t.next((int)(k / G), u); }
    __device__ __forceinline__ void a_ready(const Unit&) const {}
    __device__ __forceinline__ void done(const Unit&) const {}
};
struct SingleOrder { int pm, pn;
    __device__ bool next(int i, Unit& u) const { if (i > 0) return false; u.pm = pm; u.pn = pn; return true; }
    __device__ __forceinline__ void a_ready(const Unit&) const {}
    __device__ __forceinline__ void done(const Unit&) const {}
};
struct EpiUp {
    static constexpr bool PERM = false, AFTER_DRAIN = false;
    bf16_t* H; const PG8_LAS float* tab; mutable int ord;
    __device__ __forceinline__ void operator()(const f32x4 (&acc)[2][2][4][2], const Unit& u, int wr, int wc, int fr, int fq) const {
        const int row0 = u.pm * BM + wr * 64 + fr, col0 = u.pn * BM + wc * 32 + 8 * fq;
        const PG8_LAS float* rt = tab + ord * 512 + wr * 64 + fr; const PG8_LAS float* bt = tab + ord * 512 + 256 + wc * 32 + 8 * fq; ++ord;
#pragma unroll
        for (int bj = 0; bj < 2; ++bj) { const f32x4 b0 = *(const PG8_LAS f32x4*)(bt + bj * HALF), b1 = *(const PG8_LAS f32x4*)(bt + bj * HALF + 4);
#pragma unroll
            for (int ai = 0; ai < 2; ++ai)
#pragma unroll
                for (int m = 0; m < 4; ++m) { const float rs = rt[ai * HALF + m * 16]; f32x4 v0 = acc[ai][bj][m][0] * rs + b0, v1 = acc[ai][bj][m][1] * rs + b1;
#pragma unroll
                    for (int j = 0; j < 4; ++j) { const float a = fmaxf(v0[j], 0.f), b = fmaxf(v1[j], 0.f); v0[j] = a * a; v1[j] = b * b; }
                    u32x4 w; w.x = cvt_pk_bf16(v0[0], v0[1]); w.y = cvt_pk_bf16(v0[2], v0[3]); w.z = cvt_pk_bf16(v1[0], v1[1]); w.w = cvt_pk_bf16(v1[2], v1[3]);
                    *(u32x4*)(H + (size_t)(row0 + ai * HALF + m * 16) * 4096 + col0 + bj * HALF) = w; } }
    }
};
struct EpiRes {
    static constexpr bool PERM = false, AFTER_DRAIN = false;
    float* X; const float* gate;
    __device__ __forceinline__ void operator()(const f32x4 (&acc)[2][2][4][2], const Unit& u, int wr, int wc, int fr, int fq) const {
        const int row0 = u.pm * BM + wr * 64 + fr, col0 = u.pn * BM + wc * 32 + 8 * fq;
        const int cv = u.pm < 16 ? 0 : (u.pm < 32 ? 1 : 2);
#pragma unroll
        for (int bj = 0; bj < 2; ++bj)
#pragma unroll
            for (int n = 0; n < 2; ++n) {
                const int co = col0 + bj * HALF + 4 * n;
                const f32x4 gv = *(const f32x4*)(gate + cv * 6144 + co);
#pragma unroll
                for (int ai = 0; ai < 2; ++ai)
#pragma unroll
                    for (int m = 0; m < 4; ++m) { f32x4* px = (f32x4*)(X + (size_t)(row0 + ai * HALF + m * 16) * 1024 + co); f32x4 xv = *px; xv = xv + gv * acc[ai][bj][m][n]; *px = xv; } }
    }
};
struct EpiRes192 {
    static constexpr bool PERM = false, AFTER_DRAIN = false;
    float* X; int nh; bf16_t* HB; float* rowss; const PG8_LAS float* tab; mutable int ord;
    __device__ __forceinline__ void operator()(const f32x4 (&acc)[2][2][3][2], const Unit& u, int wr, int wc, int fr, int fq) const {
        const int row0 = u.pm * 192 + wr * 48 + fr, col0 = u.pn * BM + wc * 32 + 8 * fq;
        const PG8_LAS float* tb = tab + ord * 1536 + wc * 32 + 8 * fq; ++ord;
        float ss[2][3];
#pragma unroll
        for (int ai = 0; ai < 2; ++ai)
#pragma unroll
            for (int m = 0; m < 3; ++m) ss[ai][m] = 0.f;
#pragma unroll
        for (int bj = 0; bj < 2; ++bj) {
            f32x4 xin[2][2][3];
#pragma unroll
            for (int n = 0; n < 2; ++n)
#pragma unroll
                for (int ai = 0; ai < 2; ++ai)
#pragma unroll
                    for (int m = 0; m < 3; ++m) xin[n][ai][m] = *(const f32x4*)(X + (size_t)(row0 + ai * 96 + m * 16) * 1024 + col0 + bj * HALF + 4 * n);
#pragma unroll
            for (int n = 0; n < 2; ++n) {
                const int co = col0 + bj * HALF + 4 * n, cl = bj * HALF + 4 * n;
                const f32x4 g0 = *(const PG8_LAS f32x4*)(tb + cl), g1 = *(const PG8_LAS f32x4*)(tb + 256 + cl), g2 = *(const PG8_LAS f32x4*)(tb + 512 + cl);
                const f32x4 w0 = *(const PG8_LAS f32x4*)(tb + 768 + cl), w1 = *(const PG8_LAS f32x4*)(tb + 1024 + cl), w2 = *(const PG8_LAS f32x4*)(tb + 1280 + cl);
#pragma unroll
                for (int ai = 0; ai < 2; ++ai)
#pragma unroll
                    for (int m = 0; m < 3; ++m) { const int row = row0 + ai * 96 + m * 16; const f32x4 gv = row < 4096 ? g0 : (row < 8192 ? g1 : g2);
                        f32x4 xv = xin[n][ai][m]; xv = xv + gv * acc[ai][bj][m][n]; *(f32x4*)(X + (size_t)row * 1024 + co) = xv;
                        if (nh) { const f32x4 wv = row < 4096 ? w0 : (row < 8192 ? w1 : w2); const f32x4 y = xv * wv;
                            ss[ai][m] += (xv[0] * xv[0] + xv[1] * xv[1]) + (xv[2] * xv[2] + xv[3] * xv[3]);
                            u32x2 o; o.x = cvt_pk_bf16(y[0], y[1]); o.y = cvt_pk_bf16(y[2], y[3]); *(u32x2*)(HB + (size_t)row * 1024 + co) = o; } } } }
        if (nh) {
#pragma unroll
            for (int ai = 0; ai < 2; ++ai)
#pragma unroll
                for (int m = 0; m < 3; ++m) { float v = ss[ai][m]; v += __shfl_xor(v, 16); v += __shfl_xor(v, 32);
                    if (fq == 0) rowss[(size_t)(row0 + ai * 96 + m * 16) * 16 + u.pn * 4 + wc] = v; } }
    }
};
struct EpiPool {
    static constexpr bool PERM = false, AFTER_DRAIN = false;
    float* X; const float* xp; const float* xs; int first; const float* gate; const float* pb; const float* ps; const float* nw; const float* sc; bf16_t* HB; float* rowss;
    __device__ __forceinline__ void operator()(const f32x4 (&acc)[2][2][4][2], const Unit& u, int wr, int wc, int fr, int fq) const {
        const int g = u.pn, tile = u.pm - g * 48;
        const int row0 = tile * BM + wr * 64 + fr, col0 = g * BM + wc * 32 + 8 * fq;
        const int cv = tile < 16 ? 0 : (tile < 32 ? 1 : 2);
        const float* xold = first ? (tile < 16 ? xp : xs - (size_t)T_CTX * 1024) : X;
#pragma unroll
        for (int ai = 0; ai < 2; ++ai)
#pragma unroll
            for (int m = 0; m < 4; ++m) { const int row = row0 + ai * HALF + m * 16; float ssv = 0.f;
                f32x4 xin[2][2];
#pragma unroll
                for (int bj = 0; bj < 2; ++bj)
#pragma unroll
                    for (int n = 0; n < 2; ++n) xin[bj][n] = *(const f32x4*)(xold + (size_t)row * 1024 + col0 + bj * HALF + 4 * n);
#pragma unroll
                for (int bj = 0; bj < 2; ++bj)
#pragma unroll
                    for (int n = 0; n < 2; ++n) { const int co = col0 + bj * HALF + 4 * n; const size_t ro = (size_t)row * 1024 + co;
                        const f32x4 gv = *(const f32x4*)(gate + cv * 6144 + co), bv = *(const f32x4*)(pb + co), sv = *(const f32x4*)(ps + co);
                        const f32x4 wv = *(const f32x4*)(nw + co) * (*(const f32x4*)(sc + cv * 6144 + co) + 1.f);
                        f32x4 xv = xin[bj][n]; xv = xv + gv * ((acc[ai][bj][m][n] + bv) * sv); *(f32x4*)(X + ro) = xv;
                        const f32x4 y = xv * wv; ssv += (xv[0] * xv[0] + xv[1] * xv[1]) + (xv[2] * xv[2] + xv[3] * xv[3]);
                        u32x2 o; o.x = cvt_pk_bf16(y[0], y[1]); o.y = cvt_pk_bf16(y[2], y[3]); *(u32x2*)(HB + ro) = o; }
                ssv += __shfl_xor(ssv, 16); ssv += __shfl_xor(ssv, 32);
                if (fq == 0) rowss[(size_t)row * 16 + g * 4 + wc] = ssv; }
    }
};
struct EpiInproj {
    static constexpr bool PERM = false, AFTER_DRAIN = false;
    bf16_t *Q, *K, *V, *Gt; const float* rope; const PG8_LAS float* tab; mutable int ord;
    __device__ __forceinline__ void operator()(const f32x4 (&acc)[2][2][4][2], const Unit& u, int wr, int wc, int fr, int fq) const {
        const int pn = u.pn, row0 = u.pm * BM + wr * 64 + fr;
        const PG8_LAS float* rt = tab + ord * 512 + wr * 64 + fr; const PG8_LAS float* bp = tab + ord * 512 + 256; ++ord;
        float rstd[2][4];
#pragma unroll
        for (int ai = 0; ai < 2; ++ai)
#pragma unroll
            for (int m = 0; m < 4; ++m) rstd[ai][m] = rt[ai * HALF + m * 16];
        if (pn < 8) {
            bf16_t* dst = (pn < 4 ? Q : K) + (pn & 3) * 256;
            const float sc = pn < 4 ? 1.f : 0.0625f;
            const bool lat = u.pm >= 16;
            const int i0 = 16 * wc + 4 * fq;
#pragma unroll
            for (int ai = 0; ai < 2; ++ai)
#pragma unroll
                for (int m = 0; m < 4; ++m) { const int row = row0 + ai * HALF + m * 16; const int t = (row - T_CTX) & 4095;
#pragma unroll
                    for (int bj = 0; bj < 2; ++bj) { const int pos = bj ? (t & 63) : (t >> 6);
                        const f32x4 bb1 = *(const PG8_LAS f32x4*)(bp + bj * HALF + i0), bb2 = *(const PG8_LAS f32x4*)(bp + bj * HALF + 64 + i0);
                        f32x4 x1 = (acc[ai][bj][m][0] * rstd[ai][m] + bb1) * sc, x2 = (acc[ai][bj][m][1] * rstd[ai][m] + bb2) * sc, o1 = x1, o2 = x2;
                        if (lat) { const f32x4 c0 = *(const f32x4*)(rope + (size_t)(pos * 64 + i0) * 2), c1 = *(const f32x4*)(rope + (size_t)(pos * 64 + i0) * 2 + 4);
                            o1[0] = x1[0] * c0[0] - x2[0] * c0[1]; o2[0] = x2[0] * c0[0] + x1[0] * c0[1];
                            o1[1] = x1[1] * c0[2] - x2[1] * c0[3]; o2[1] = x2[1] * c0[2] + x1[1] * c0[3];
                            o1[2] = x1[2] * c1[0] - x2[2] * c1[1]; o2[2] = x2[2] * c1[0] + x1[2] * c1[1];
                            o1[3] = x1[3] * c1[2] - x2[3] * c1[3]; o2[3] = x2[3] * c1[2] + x1[3] * c1[3]; }
                        bf16_t* rp = dst + (size_t)row * 1024 + bj * HALF + i0;
                        u32x2 w1, w2; w1.x = cvt_pk_bf16(o1[0], o1[1]); w1.y = cvt_pk_bf16(o1[2], o1[3]); w2.x = cvt_pk_bf16(o2[0], o2[1]); w2.y = cvt_pk_bf16(o2[2], o2[3]);
                        *(u32x2*)rp = w1; *(u32x2*)(rp + 64) = w2; } }
        } else {
            bf16_t* dst = (pn < 16 ? V + (pn - 8) * 256 : Gt + (pn - 16) * 256) + wc * 32 + 8 * fq;
#pragma unroll
            for (int ai = 0; ai < 2; ++ai)
#pragma unroll
                for (int m = 0; m < 4; ++m) { bf16_t* rowp = dst + (size_t)(row0 + ai * HALF + m * 16) * 2048;
#pragma unroll
                    for (int bj = 0; bj < 2; ++bj) { const f32x4 b0 = *(const PG8_LAS f32x4*)(bp + bj * HALF + wc * 32 + 8 * fq), b1 = *(const PG8_LAS f32x4*)(bp + bj * HALF + wc * 32 + 8 * fq + 4);
                        const f32x4 v0 = acc[ai][bj][m][0] * rstd[ai][m] + b0, v1 = acc[ai][bj][m][1] * rstd[ai][m] + b1;
                        u32x4 w; w.x = cvt_pk_bf16(v0[0], v0[1]); w.y = cvt_pk_bf16(v0[2], v0[3]); w.z = cvt_pk_bf16(v1[0], v1[1]); w.w = cvt_pk_bf16(v1[2], v1[3]);
                        *(u32x4*)(rowp + bj * HALF) = w; } }
        }
    }
};
template <class Epi, class Sched, bool ALIGN_EPI = false, bool SP2 = false, int MF = 4>
__device__ __forceinline__ void gemm_phase(PG8_LAS unsigned char* lds, const Gemm g, const Sched& S, const Epi& E, int tid_in) {
    int tid_ = tid_in; asm volatile("" : "+v"(tid_)); const int tid = tid_, wid = __builtin_amdgcn_readfirstlane(tid >> 6), lane = tid & 63, wr = wid >> 2, wc = wid & 3, fr = lane & 15, fq = lane >> 4;
    const int K = g.K, nt = K / BK;
    unsigned voffA[2], voffB[2];
#pragma unroll
    for (int i = 0; i < 2; ++i) { int R, C; stage_rc(tid * 16 + i * 8192, R, C); const int Rb = Epi::PERM ? ((R & ~31) + perm32(R & 31)) : R;
        voffA[i] = (unsigned)(R * K + C) * 2u; voffB[i] = (unsigned)(Rb * K + C) * 2u; }
    const size_t kstep = (size_t)(BK * 2);
    const size_t hstep = (size_t)HALF * K * 2, hstepA = (size_t)(32 * MF) * K * 2;
    const size_t tstep = 2 * hstep, tstepA = 2 * hstepA;
    const unsigned ldsw = (unsigned)wid * 1024u;
    const int aoff = lds_byte(wr * (16 * MF) + fr, fq * 8), boff = lds_byte(wc * 32 + fr, fq * 8);
#define PG8_SA(b, h) (((b) * 2 + (h)) * HTB)
#define PG8_SB(b, h) ((4 + (b) * 2 + (h)) * HTB)
#define PG8_STAGE(bufoff, gbase, voff) do { _Pragma("unroll") for (int _i = 0; _i < 2; ++_i) \
        __builtin_amdgcn_global_load_lds((const unsigned*)((const char*)(gbase) + (voff)[_i]), (PG8_LAS unsigned*)(lds + (bufoff) + ldsw + _i * 8192), 16, 0, 0); } while (0)
#define PG8_LDA(dst, b, h) do { _Pragma("unroll") for (int m = 0; m < MF; ++m) _Pragma("unroll") for (int k = 0; k < 2; ++k) dst[m][k] = *(const PG8_LAS bf16x8*)(lds + PG8_SA(b, h) + aoff + m * 2048 + k * 1024); } while (0)
#define PG8_LDB(dst, b, h) do { _Pragma("unroll") for (int n = 0; n < 2; ++n) _Pragma("unroll") for (int k = 0; k < 2; ++k) dst[n][k] = *(const PG8_LAS bf16x8*)(lds + PG8_SB(b, h) + boff + n * 2048 + k * 1024); } while (0)
#define PG8_MMA(ai, bj, At, Bt) do { __builtin_amdgcn_s_setprio(1); _Pragma("unroll") for (int m = 0; m < MF; ++m) _Pragma("unroll") for (int n = 0; n < 2; ++n) _Pragma("unroll") for (int k = 0; k < 2; ++k) \
        acc[ai][bj][m][n] = __builtin_amdgcn_mfma_f32_16x16x32_bf16(Bt[n][k], At[m][k], acc[ai][bj][m][n], 0, 0, 0); __builtin_amdgcn_s_setprio(0); } while (0)
#define PG8_WAIT_V(n) asm volatile("s_waitcnt vmcnt(" #n ")" ::: "memory")
#define PG8_WAIT_L(n) asm volatile("s_waitcnt lgkmcnt(" #n ")" ::: "memory")
#define PG8_BAR __builtin_amdgcn_s_barrier()
#define PG8_SCHED __builtin_amdgcn_sched_barrier(0)
    Unit cur, nxt; int ui = 0;
    if (!S.next(0, cur)) return;
    f32x4 acc[2][2][MF][2];
#pragma unroll
    for (int a = 0; a < 2; ++a)
#pragma unroll
        for (int b = 0; b < 2; ++b)
#pragma unroll
            for (int m = 0; m < MF; ++m)
#pragma unroll
                for (int n = 0; n < 2; ++n) acc[a][b][m][n] = (f32x4){0.f, 0.f, 0.f, 0.f};
    bf16x8 At[MF][2], B0[2][2], B1[2][2];
    const char* cA = (const char*)g.A + (size_t)cur.pm * tstepA; const char* cB = (const char*)g.Bt + (size_t)cur.pn * tstep;
    S.a_ready(cur);
    if constexpr (SP2) {
        PG8_STAGE(PG8_SB(0, 0), cB, voffB); PG8_STAGE(PG8_SB(0, 1), cB + hstep, voffB); PG8_STAGE(PG8_SA(0, 0), cA, voffA); PG8_STAGE(PG8_SA(0, 1), cA + hstepA, voffA);
        if (wr == 1) PG8_BAR;
        PG8_WAIT_V(2); PG8_BAR;
        PG8_STAGE(PG8_SB(1, 0), cB + kstep, voffB); PG8_STAGE(PG8_SA(1, 0), cA + kstep, voffA); PG8_STAGE(PG8_SB(1, 1), cB + hstep + kstep, voffB);
        PG8_WAIT_V(6); PG8_BAR;
    } else {
        PG8_STAGE(PG8_SB(0, 0), cB, voffB); PG8_STAGE(PG8_SA(0, 0), cA, voffA); PG8_STAGE(PG8_SB(0, 1), cB + hstep, voffB); PG8_STAGE(PG8_SA(0, 1), cA + hstepA, voffA);
        if (wr == 1) PG8_BAR;
        PG8_WAIT_V(4); PG8_BAR;
        PG8_STAGE(PG8_SB(1, 0), cB + kstep, voffB); PG8_STAGE(PG8_SA(1, 0), cA + kstep, voffA); PG8_STAGE(PG8_SB(1, 1), cB + hstep + kstep, voffB);
        PG8_WAIT_V(6); PG8_BAR;
    }
    for (;;) {
        const bool has_next = S.next(ui + 1, nxt);
        const char* nA = has_next ? (const char*)g.A + (size_t)nxt.pm * tstepA : cA; const char* nB = has_next ? (const char*)g.Bt + (size_t)nxt.pn * tstep : cB;
        for (int t = 0; t < nt; t += 2) {
            const bool last = (t == nt - 2);
            const char* a1 = cA + (size_t)(t + 1) * kstep;
            const char* a2 = last ? nA : cA + (size_t)(t + 2) * kstep; const char* b2 = last ? nB : cB + (size_t)(t + 2) * kstep;
            const char* a3 = a2 + kstep; const char* b3 = b2 + kstep;
            if (last && has_next) S.a_ready(nxt);
            if constexpr (SP2) {
            PG8_LDB(B0, 0, 0); PG8_LDB(B1, 0, 1); PG8_SCHED; PG8_LDA(At, 0, 0); PG8_STAGE(PG8_SA(1, 1), a1 + hstepA, voffA);
            PG8_WAIT_V(8); PG8_WAIT_L(0); PG8_BAR; PG8_MMA(0, 0, At, B0); PG8_MMA(0, 1, At, B1); PG8_BAR; PG8_SCHED;
            PG8_LDA(At, 0, 1); PG8_STAGE(PG8_SB(0, 0), b2, voffB); PG8_STAGE(PG8_SB(0, 1), b2 + hstep, voffB); PG8_STAGE(PG8_SA(0, 0), a2, voffA);
            PG8_WAIT_V(8); PG8_WAIT_L(0); PG8_BAR; PG8_MMA(1, 0, At, B0); PG8_MMA(1, 1, At, B1); PG8_BAR; PG8_SCHED;
            PG8_LDB(B0, 1, 0); PG8_LDB(B1, 1, 1); PG8_SCHED; PG8_LDA(At, 1, 0); PG8_STAGE(PG8_SA(0, 1), a2 + hstepA, voffA);
            PG8_WAIT_V(8); PG8_WAIT_L(0); PG8_BAR; PG8_MMA(0, 0, At, B0); PG8_MMA(0, 1, At, B1); PG8_BAR; PG8_SCHED;
            PG8_LDA(At, 1, 1); PG8_STAGE(PG8_SB(1, 0), b3, voffB); PG8_STAGE(PG8_SB(1, 1), b3 + hstep, voffB); PG8_STAGE(PG8_SA(1, 0), a3, voffA);
            PG8_WAIT_V(8); PG8_WAIT_L(0); PG8_BAR; PG8_MMA(1, 0, At, B0); PG8_MMA(1, 1, At, B1); PG8_BAR; PG8_SCHED;
            } else {
            PG8_LDB(B0, 0, 0); PG8_SCHED; PG8_LDA(At, 0, 0); PG8_STAGE(PG8_SA(1, 1), a1 + hstepA, voffA);
            PG8_WAIT_L(8); PG8_BAR; PG8_WAIT_L(0); PG8_MMA(0, 0, At, B0); PG8_BAR; PG8_SCHED;
            PG8_LDB(B1, 0, 1); PG8_STAGE(PG8_SB(0, 0), b2, voffB);
            PG8_BAR; PG8_WAIT_L(0); PG8_MMA(0, 1, At, B1); PG8_BAR;
            PG8_LDA(At, 0, 1); PG8_STAGE(PG8_SA(0, 0), a2, voffA);
            PG8_BAR; PG8_WAIT_L(0); PG8_MMA(1, 0, At, B0); PG8_BAR; PG8_SCHED;
            PG8_STAGE(PG8_SB(0, 1), b2 + hstep, voffB);
            PG8_WAIT_V(6); PG8_BAR; PG8_MMA(1, 1, At, B1); PG8_BAR;
            PG8_LDB(B0, 1, 0); PG8_SCHED; PG8_LDA(At, 1, 0); PG8_STAGE(PG8_SA(0, 1), a2 + hstepA, voffA);
            PG8_WAIT_L(8); PG8_BAR; PG8_WAIT_L(0); PG8_MMA(0, 0, At, B0); PG8_BAR; PG8_SCHED;
            PG8_LDB(B1, 1, 1); PG8_STAGE(PG8_SB(1, 0), b3, voffB);
            PG8_BAR; PG8_WAIT_L(0); PG8_MMA(0, 1, At, B1); PG8_BAR;
            PG8_LDA(At, 1, 1); PG8_STAGE(PG8_SA(1, 0), a3, voffA);
            PG8_BAR; PG8_WAIT_L(0); PG8_MMA(1, 0, At, B0); PG8_BAR; PG8_SCHED;
            PG8_STAGE(PG8_SB(1, 1), b3 + hstep, voffB);
            PG8_WAIT_V(6); PG8_BAR; PG8_MMA(1, 1, At, B1); PG8_BAR;
            }
        }
        if constexpr (ALIGN_EPI) { if (wr == 0) PG8_BAR; }
        if constexpr (!Epi::AFTER_DRAIN) { E(acc, cur, wr, wc, fr, fq); S.done(cur); }
        if (!has_next) break;
#pragma unroll
        for (int a = 0; a < 2; ++a)
#pragma unroll
            for (int b = 0; b < 2; ++b)
#pragma unroll
                for (int m = 0; m < MF; ++m)
#pragma unroll
                    for (int n = 0; n < 2; ++n) acc[a][b][m][n] = (f32x4){0.f, 0.f, 0.f, 0.f};
        cur = nxt; cA = nA; cB = nB; ++ui;
        if constexpr (ALIGN_EPI) { if (wr == 1) PG8_BAR; }
    }
    PG8_WAIT_V(0);
    if constexpr (!ALIGN_EPI) { if (wr == 0) PG8_BAR; }
    PG8_BAR;
    if constexpr (Epi::AFTER_DRAIN) { E.fused(acc, cur, wr, wc, fr, fq, lds, wid, lane); S.done(cur); }
#undef PG8_SA
#undef PG8_SB
#undef PG8_STAGE
#undef PG8_LDA
#undef PG8_LDB
#undef PG8_MMA
#undef PG8_WAIT_V
#undef PG8_WAIT_L
#undef PG8_BAR
#undef PG8_SCHED
}
}
#define XB_TMO      128
#define XB_XCNT(j)  (256  + 64 * (j))
#define XB_XSUB(j)  (1280 + 64 * (j))
#define XB_XGEN(j)  (2304 + 64 * (j))
#define XB_TOP      3328
#define XB_TOPGEN   3392
#define XCD_BAR_WORDS 3456
#define XB_SPIN_CAP (1u << 18)

__device__ __forceinline__ unsigned xb_ld(unsigned* p)              { return __hip_atomic_load(p, __ATOMIC_RELAXED, __HIP_MEMORY_SCOPE_AGENT); }
__device__ __forceinline__ unsigned xb_add(unsigned* p, unsigned v) { return __hip_atomic_fetch_add(p, v, __ATOMIC_RELAXED, __HIP_MEMORY_SCOPE_AGENT); }
__device__ __forceinline__ unsigned xb_xcc_id() { return (unsigned)__builtin_amdgcn_s_getreg((3 << 11) | 20) & 0xFu; }
#define XB_SPIN(cond, bar) do { unsigned _sp = 0; while (cond) { __builtin_amdgcn_s_sleep(1); \
    if ((++_sp & 255u) == 0u) { if (xb_ld(&(bar)[XB_TMO])) break; if (_sp > XB_SPIN_CAP) { atomicAdd(&(bar)[XB_TMO], 1u); break; } } } } while (0)

struct XcdBarrier {
    int w0;
    unsigned* bar; unsigned x;
    volatile LAS unsigned* st;
};

__device__ __forceinline__ XcdBarrier xcd_barrier_post(unsigned* bar, volatile LAS unsigned* st) {
    XcdBarrier b; b.bar = bar; b.x = xb_xcc_id(); b.st = st;
    if (threadIdx.x == 0) (void)xb_add(&bar[XB_XCNT(b.x)], 1u);
    return b;
}
__device__ __forceinline__ void xcd_barrier_complete(unsigned* bar, unsigned x, unsigned& nloc, unsigned& nx) {
    const unsigned G = gridDim.x * gridDim.y * gridDim.z;
    unsigned sum, cnt, mine, sp = 0u;
    for (;;) {
        sum = 0u; cnt = 0u; mine = 0u;
#pragma unroll
        for (unsigned j = 0; j < 16; ++j) { const unsigned c = xb_ld(&bar[XB_XCNT(j)]); sum += c; cnt += (c > 0u) ? 1u : 0u; mine = (j == x) ? c : mine; }
        if (sum == G) break;
        __builtin_amdgcn_s_sleep(1);
        if ((++sp & 255u) == 0u) { if (xb_ld(&bar[XB_TMO])) break; if (sp > XB_SPIN_CAP) { atomicAdd(&bar[XB_TMO], 1u); break; } }
    }
    nloc = mine > 0u ? mine : 1u; nx = cnt > 0u ? cnt : 1u;
}

__device__ __forceinline__ void xcd_barrier(const XcdBarrier& b) {
    asm volatile("s_waitcnt vmcnt(0)" ::: "memory");
    __syncthreads();
    if (tid_from_wave(b.w0) == 0) {
        unsigned* bar = b.bar;
        __builtin_amdgcn_s_waitcnt(0);
        unsigned nloc = b.st[0], nx = b.st[1];
        if (nloc == 0u) { xcd_barrier_complete(bar, b.x, nloc, nx); b.st[0] = nloc; b.st[1] = nx; }
        const unsigned old = xb_add(&bar[XB_XSUB(b.x)], 1u);
        const unsigned gen = old / nloc;
        if (old + 1u == (gen + 1u) * nloc) {
            __builtin_amdgcn_fence(__ATOMIC_RELEASE, "agent");
            asm volatile("s_waitcnt vmcnt(0)" ::: "memory");
            const unsigned og = xb_add(&bar[XB_TOP], 1u);
            const unsigned tg = og / nx;
            if (og + 1u == (tg + 1u) * nx) xb_add(&bar[XB_TOPGEN], 1u);
            else XB_SPIN(xb_ld(&bar[XB_TOPGEN]) == tg, bar);
            __builtin_amdgcn_fence(__ATOMIC_ACQUIRE, "agent");
            xb_add(&bar[XB_XGEN(b.x)], 1u);
            asm volatile("s_waitcnt vmcnt(0)" ::: "memory");
        } else {
            XB_SPIN(xb_ld(&bar[XB_XGEN(b.x)]) == gen, bar);
            __builtin_amdgcn_fence(__ATOMIC_ACQUIRE, "agent");
            asm volatile("s_waitcnt vmcnt(0)" ::: "memory");
        }
    }
    __syncthreads();
}

struct Ctx { const Params* p; unsigned char* ws; float* out; LAS unsigned char* lds; int tid, lane, wave, gw, ngw, bid, G; };
__device__ __forceinline__ Ctx fresh_ctx(const Params* pp, LAS unsigned char* lds, int wave0);
__device__ __forceinline__ Ctx fresh_ctx(const Params* pp, LAS unsigned char* lds, int wave0) {
    Ctx c; c.p = pp; c.lds = lds;
    int tid = tid_from_wave(wave0); asm volatile("" : "+v"(tid));
    int bid = blockIdx.x; asm volatile("" : "+s"(bid));
    int G = gridDim.x; asm volatile("" : "+s"(G));
    unsigned char* ws = pp->ws; asm volatile("" : "+s"(ws));
    float* out = pp->out; asm volatile("" : "+s"(out));
    c.tid = tid; c.lane = tid & 63; c.wave = __builtin_amdgcn_readfirstlane(tid >> 6); c.bid = bid; c.G = G; c.ws = ws; c.out = out; c.gw = bid * NWAVES + c.wave; c.ngw = G * NWAVES;
    return c;
}
__device__ __forceinline__ const float* inp(const Ctx& c, int i) { asm volatile("" : "+s"(i)); return c.p->in[i]; }

__device__ __forceinline__ void p0_transpose_item(const float* W, int K, int N, bf16_t* WT, LAS float* scr, int item, int lane, int mode, const float* sh = nullptr, float* biasp = nullptr) {
    const int nblk = N / 32, kb = item / nblk, nb = item % nblk, k0 = 64 * kb, n0 = 32 * nb;
#pragma unroll 8
    for (int i = 0; i < 32; ++i) { const int kk = 2 * i + (lane >> 5); scr[kk * 33 + (lane & 31)] = W[(size_t)(k0 + kk) * N + n0 + (lane & 31)]; }
    if (sh) { LAS float* shl = scr + 64 * 33;
#pragma unroll
        for (int cvv = 0; cvv < 3; ++cvv) shl[cvv * 64 + lane] = sh[(size_t)cvv * NMOD + k0 + lane]; }
    asm volatile("s_waitcnt lgkmcnt(0)" ::: "memory");
    if (sh) { const LAS float* shl = scr + 64 * 33; const int n = lane & 31, kh = (lane >> 5) * 32; float a0 = 0.f, a1 = 0.f, a2 = 0.f;
#pragma unroll 8
        for (int kk = 0; kk < 32; ++kk) { const float wv = scr[(kh + kk) * 33 + n]; a0 += shl[kh + kk] * wv; a1 += shl[64 + kh + kk] * wv; a2 += shl[128 + kh + kk] * wv; }
        a0 += __shfl_xor(a0, 32); a1 += __shfl_xor(a1, 32); a2 += __shfl_xor(a2, 32);
        if (lane < 32) { float* o = biasp + (size_t)(kb * 3) * N + n0 + n; o[0] = a0; o[N] = a1; o[2 * (size_t)N] = a2; } }
    const int c = lane & 7;
#pragma unroll
    for (int j = 0; j < 4; ++j) { const int n = (lane >> 3) + 8 * j; const LAS float* s = scr + (8 * c) * 33 + n;
        u32x4 o; o.x = cvt_pk_bf16(s[0 * 33], s[1 * 33]); o.y = cvt_pk_bf16(s[2 * 33], s[3 * 33]); o.z = cvt_pk_bf16(s[4 * 33], s[5 * 33]); o.w = cvt_pk_bf16(s[6 * 33], s[7 * 33]);
        const int L = n0 + n, Pn = (mode == 1 && L < 2048) ? permrope(L) : perm8(L);
        *(u32x4*)(WT + (size_t)Pn * K + k0 + 8 * c) = o; }
    asm volatile("s_waitcnt lgkmcnt(0)" ::: "memory");
}
__device__ __forceinline__ void phase_p0(const Ctx& c) {
    unsigned char* ws = c.ws;
    { LAS float* sl = (LAS float*)c.lds;
      float* modp = (float*)(ws + WS_MODP);
      for (int u = c.bid; u < 768; u += c.G) {
        const int l = u / 192, rem = u % 192, kc = rem / 12, nb = rem % 12, n = nb * 512 + c.tid;
        __syncthreads();
        if (c.tid < 192) { const int cvv = c.tid >> 6, k = 64 * kc + (c.tid & 63); const float v = cvv == 0 ? inp(c, I_CCTX)[k] : inp(c, I_C)[(cvv - 1) * 1024 + k]; sl[c.tid] = silu_f(v); }
        __syncthreads();
        float a0 = 0.f, a1 = 0.f, a2 = 0.f; const float* w = inp(c, I_WADA) + ((size_t)l * 1024 + 64 * kc) * NMOD + n;
#pragma unroll 8
        for (int k = 0; k < 64; ++k) { const float wv = w[(size_t)k * NMOD]; a0 += sl[k] * wv; a1 += sl[64 + k] * wv; a2 += sl[128 + k] * wv; }
        float* o = modp + (size_t)((l * 16 + kc) * 3) * NMOD + n; o[0] = a0; o[NMOD] = a1; o[2 * NMOD] = a2;
      }
      __syncthreads();
    }
    { float* rope = (float*)(ws + WS_TAB + TAB_ROPE); float* pw = (float*)(ws + WS_TAB + TAB_POW);
      const int gt = c.bid * NTHREADS + c.tid, ngt = c.G * NTHREADS;
      for (int i = gt; i < 4096; i += ngt) { const int pos = i >> 6, fi = i & 63; const float fr = powf(10000.f, -(float)fi / 64.f); const float ang = (float)pos * fr; rope[2 * i] = cosf(ang); rope[2 * i + 1] = sinf(ang); }
      for (int i = gt; i < 16 * 132; i += ngt) { const int n = i % 132, q = i / 132; const float lg = log1pf(-exp2f(-inp(c, I_DECAY)[q])); pw[i] = expf(lg * (float)n); }
    }
    { LAS float* scr = (LAS float*)(c.lds + c.wave * 9216);
      constexpr int I2 = 2048, IOUT = 1024, IP = 32;
      constexpr int NIT = 4 * I2 + 2 * IOUT + 8 * IP;
      for (int it = c.gw; it < NIT; it += c.ngw) {
        int r = it;
        if (r < 4 * I2) { const int l = r / I2; p0_transpose_item(inp(c, I_W2) + (size_t)l * 4096 * 1024, 4096, 1024, (bf16_t*)(ws + WS_W2T) + (size_t)l * 1024 * 4096, scr, r % I2, c.lane, 0); continue; } r -= 4 * I2;
        if (r < 2 * IOUT) { const int l = r / IOUT; p0_transpose_item(inp(c, I_WOUT) + (size_t)l * HV * 1024, HV, 1024, (bf16_t*)(ws + WS_WOUTT) + (size_t)l * 1024 * HV, scr, r % IOUT, c.lane, 0); continue; } r -= 2 * IOUT;
        { const int l = r / IP; p0_transpose_item(inp(c, I_PW) + (size_t)l * 65536, 256, 256, (bf16_t*)(ws + WS_PWT) + (size_t)l * 65536, scr, r % IP, c.lane, 0); }
      }
    }
}
__device__ __forceinline__ void phase_p0c(const Ctx& c) {
    unsigned char* ws = c.ws; const float* mod = (const float*)(ws + WS_MOD); float* biasp = (float*)(ws + WS_BIASP);
    LAS float* scr = (LAS float*)(c.lds + c.wave * 9216);
    constexpr int I1 = 2048, IIN = 3072, NIT = 4 * I1 + 2 * IIN;
    for (int it = c.gw; it < NIT; it += c.ngw) {
        int r = it;
        if (r < 4 * I1) { const int l = r / I1; p0_transpose_item(inp(c, I_W1) + (size_t)l * 1024 * 4096, 1024, 4096, (bf16_t*)(ws + WS_W1T) + (size_t)l * 4096 * 1024, scr, r % I1, c.lane, 0,
                                                                   mod + (size_t)(l * 3) * NMOD + 3 * 1024, biasp + (size_t)l * 16 * 3 * 4096); continue; } r -= 4 * I1;
        { const int jr = r / IIN, l = 2 * jr + 1; p0_transpose_item(inp(c, I_WIN) + (size_t)jr * 1024 * RIN, 1024, RIN, (bf16_t*)(ws + WS_WINT) + (size_t)jr * RIN * 1024, scr, r % IIN, c.lane, 1,
                                                                   mod + (size_t)(l * 3) * NMOD, biasp + (size_t)4 * 16 * 3 * 4096 + (size_t)jr * 16 * 3 * RIN); }
    }
}
__device__ __forceinline__ void bias_finalize(const Ctx& c) {
    const float* biasp = (const float*)(c.ws + WS_BIASP); float* bu = (float*)(c.ws + WS_BIASU); float* bi = (float*)(c.ws + WS_BIASI);
    const int gt = c.bid * NTHREADS + c.tid, ngt = c.G * NTHREADS;
    for (int i = gt; i < 4 * 3 * 4096 + 2 * 3 * RIN; i += ngt) {
        const bool up = i < 4 * 3 * 4096; const int q = up ? i : i - 4 * 3 * 4096, N = up ? 4096 : RIN, n = q % N, cvv = (q / N) % 3, l = q / (3 * N);
        const float* src = biasp + (up ? (size_t)l * 16 * 3 * 4096 : (size_t)4 * 16 * 3 * 4096 + (size_t)l * 16 * 3 * RIN) + (size_t)cvv * N + n;
        float s = 0.f;
#pragma unroll
        for (int kb = 0; kb < 16; ++kb) s += src[(size_t)kb * 3 * N];
        (up ? bu : bi)[q] = s; }
}
__device__ __forceinline__ void phase_p0b(const Ctx& c) {
    const float* modp = (const float*)(c.ws + WS_MODP); float* mod = (float*)(c.ws + WS_MOD);
    const int gt = c.bid * NTHREADS + c.tid, ngt = c.G * NTHREADS;
    for (int i = gt; i < 4 * 3 * NMOD; i += ngt) { const int n = i % NMOD, cvv = (i / NMOD) % 3, l = i / (3 * NMOD);
        float s = inp(c, I_BADA)[l * NMOD + n];
#pragma unroll
        for (int kc = 0; kc < 16; ++kc) s += modp[(size_t)((l * 16 + kc) * 3 + cvv) * NMOD + n];
        mod[i] = s; }
}
template <int MODE> __device__ __forceinline__ void phase_norm(const Ctx& c, int l, int which, int from_input) {
    const float* X = (const float*)(c.ws + WS_X); const float* mod = (const float*)(c.ws + WS_MOD);
    const float* nw = MODE == 2 ? inp(c, I_FNW) : (which ? inp(c, I_NMLP) : inp(c, I_NMIX)) + l * 1024;
    for (int row = c.gw; row < T; row += c.ngw) {
        const float* xr = from_input ? (row < T_CTX ? inp(c, I_XP) + (size_t)row * 1024 : inp(c, I_XS) + (size_t)(row - T_CTX) * 1024) : X + (size_t)row * 1024;
        f32x4 v[4]; float ss = 0.f;
#pragma unroll
        for (int j = 0; j < 4; ++j) { v[j] = *(const f32x4*)(xr + 4 * c.lane + 256 * j); ss += (v[j][0] * v[j][0] + v[j][1] * v[j][1]) + (v[j][2] * v[j][2] + v[j][3] * v[j][3]); }
        const float rstd = rsqrtf(wave_sum(ss) * (1.f / 1024.f) + NORM_EPS);
        const float* mrow = mod + (size_t)(l * 3 + cv_of_row(row)) * NMOD + (which ? 3 : 0) * 1024;
#pragma unroll
        for (int j = 0; j < 4; ++j) { const int col = 4 * c.lane + 256 * j; const f32x4 w = *(const f32x4*)(nw + col); f32x4 h = v[j] * rstd * w;
            if (MODE != 2) { const f32x4 sh = *(const f32x4*)(mrow + col), sc = *(const f32x4*)(mrow + 1024 + col); h = h * (sc + 1.f) + sh; }
            if (MODE == 0) { u32x2 o; o.x = cvt_pk_bf16(h[0], h[1]); o.y = cvt_pk_bf16(h[2], h[3]); *(u32x2*)((bf16_t*)(c.ws + WS_HB) + (size_t)row * 1024 + col) = o; }
            else if (MODE == 1) { u32x2 o; o.x = cvt_pk_bf16(h[0], h[1]); o.y = cvt_pk_bf16(h[2], h[3]); *(u32x2*)((bf16_t*)(c.ws + WS_HF32) + (size_t)row * 1024 + col) = o; }
            else __builtin_nontemporal_store(h, (f32x4*)(c.out + (size_t)row * 1024 + col)); }
    }
}
__device__ __forceinline__ void up8(const u32x4 v, f32x4& a, f32x4& b) {
    a = (f32x4){bf2f(v.x & 0xffffu), bf2f(v.x >> 16), bf2f(v.y & 0xffffu), bf2f(v.y >> 16)}; b = (f32x4){bf2f(v.z & 0xffffu), bf2f(v.z >> 16), bf2f(v.w & 0xffffu), bf2f(v.w >> 16)}; }
__device__ __forceinline__ u32x4 pk8(const f32x4 a, const f32x4 b) { u32x4 o; o.x = cvt_pk_bf16(a[0], a[1]); o.y = cvt_pk_bf16(a[2], a[3]); o.z = cvt_pk_bf16(b[0], b[1]); o.w = cvt_pk_bf16(b[2], b[3]); return o; }
__device__ __forceinline__ void slide16b(const bf16_t* src, int base, int stride, int L, int w, int p0, const bf16_t* hsub, u32x4 (&outp)[16]) {
    const int h2 = w >> 1;
    const int lo0 = max(p0 - h2, 0), hi0 = min(p0 - h2 + w, L);
    f32x4 Sa = {0.f, 0.f, 0.f, 0.f}, Sb = {0.f, 0.f, 0.f, 0.f};
#pragma unroll
    for (int k = 0; k < 16; ++k) { const int q = lo0 + k; f32x4 a, b; up8(*(const u32x4*)(src + (size_t)(base + min(q, L - 1) * stride) * 1024), a, b); if (q < hi0) { Sa = Sa + a; Sb = Sb + b; } }
#pragma unroll
    for (int k = 0; k < 16; ++k) { const int p = p0 + k;
        if (k > 0) { const int qa = p - 1 - h2, qb = p - h2 + w - 1; f32x4 a0, b0, a1, b1;
            up8(*(const u32x4*)(src + (size_t)(base + max(qa, 0) * stride) * 1024), a0, b0); up8(*(const u32x4*)(src + (size_t)(base + min(qb, L - 1) * stride) * 1024), a1, b1);
            if (qa >= 0) { Sa = Sa - a0; Sb = Sb - b0; }
            if (qb < L) { Sa = Sa + a1; Sb = Sb + b1; } }
        const int lo = max(p - h2, 0), hi = min(p - h2 + w, L); const float inv = 1.f / (float)(hi - lo);
        f32x4 ma = Sa * inv, mb = Sb * inv;
        if (hsub) { f32x4 ha, hb; up8(*(const u32x4*)(hsub + (size_t)(base + p * stride) * 1024), ha, hb); ma = ma - ha; mb = mb - hb; }
        outp[k] = pk8(ma, mb); }
}
__device__ __forceinline__ void phase_pool_v(const Ctx& c) {
    const bf16_t* hf = (const bf16_t*)(c.ws + WS_HF32); bf16_t* vs = (bf16_t*)(c.ws + WS_VS);
    const int gt = c.bid * NTHREADS + c.tid, ngt = c.G * NTHREADS;
    for (int i = gt; i < 768 * 128; i += ngt) { const int seg = i >> 7, ch = (i & 127) * 8, w = 2 << (ch >> 8);
        int base, stride, L, p0;
        if (seg < 256) { base = (seg >> 4) * 256; stride = 1; L = 256; p0 = (seg & 15) * 16; }
        else { const int s2 = seg - 256, cc = s2 & 63, rs = (s2 >> 6) & 3, b = s2 >> 8; base = T_CTX + b * 4096 + cc; stride = 64; L = 64; p0 = rs * 16; }
        u32x4 o[16];
        slide16b(hf + ch, base, stride, L, w, p0, nullptr, o);
#pragma unroll
        for (int k = 0; k < 16; ++k) *(u32x4*)(vs + (size_t)(base + (p0 + k) * stride) * 1024 + ch) = o[k]; }
}
__device__ __forceinline__ void phase_pool_h(const Ctx& c) {
    const bf16_t* hf = (const bf16_t*)(c.ws + WS_HF32); const bf16_t* vs = (const bf16_t*)(c.ws + WS_VS); bf16_t* db = (bf16_t*)(c.ws + WS_DBUF);
    const int gt = c.bid * NTHREADS + c.tid, ngt = c.G * NTHREADS;
    for (int i = gt; i < 768 * 128; i += ngt) { const int seg = i >> 7, ch = (i & 127) * 8, g = ch >> 8, w = 2 << g;
        const int t0 = seg * 16;
        u32x4 o[16];
        if (seg < 256) {
            u32x4 mv[16], hv[16];
#pragma unroll
            for (int k = 0; k < 16; ++k) { mv[k] = *(const u32x4*)(vs + (size_t)(t0 + k) * 1024 + ch); hv[k] = *(const u32x4*)(hf + (size_t)(t0 + k) * 1024 + ch); }
#pragma unroll
            for (int k = 0; k < 16; ++k) { f32x4 ma, mb, ha, hb; up8(mv[k], ma, mb); up8(hv[k], ha, hb); o[k] = pk8(ma - ha, mb - hb); }
        } else slide16b(vs + ch, t0 & ~63, 1, 64, w, t0 & 63, hf + ch, o);
#pragma unroll
        for (int k = 0; k < 16; ++k) *(u32x4*)(db + ((size_t)g * T + t0 + k) * 256 + (ch & 255)) = o[k]; }
}
__device__ __forceinline__ void phase_tr(const Ctx& c) {
    LAS unsigned char* scr = c.lds + c.wave * 8448;
    const int lane = c.lane;
#define TR_LOAD(dst8, item) do { const int tb_ = (item) % 192, cb_ = (item) / 192; const bf16_t* src_ = cb_ < 16 ? (const bf16_t*)(c.ws + WS_K) + cb_ * 64 : (const bf16_t*)(c.ws + WS_V) + (cb_ - 16) * 64; const int ld_ = cb_ < 16 ? 1024 : 2048; \
    _Pragma("unroll") for (int i = 0; i < 8; ++i) { const int pc = lane + 64 * i; dst8[i] = *(const u32x4*)(src_ + (size_t)(tb_ * 64 + (pc >> 3)) * ld_ + (pc & 7) * 8); } } while (0)
    u32x4 cur[8], nxt[8];
    if (c.gw < 192 * 48) TR_LOAD(cur, c.gw);
    for (int it = c.gw; it < 192 * 48; it += c.ngw) {
        const int tb = it % 192, cb = it / 192;
        bf16_t* dst = cb < 16 ? (bf16_t*)(c.ws + WS_KT) + (size_t)(cb * 64) * T : (bf16_t*)(c.ws + WS_VT) + (size_t)((cb - 16) * 64) * T;
        const int tok0 = tb * 64;
        const bool more = it + c.ngw < 192 * 48;
        if (more) TR_LOAD(nxt, it + c.ngw);
#pragma unroll
        for (int i = 0; i < 8; ++i) { const int pc = lane + 64 * i, r = pc >> 3, ch = pc & 7; const u32x4 v = cur[i];
            LAS unsigned* d = (LAS unsigned*)(scr + r * 132 + ch * 16); d[0] = v.x; d[1] = v.y; d[2] = v.z; d[3] = v.w; }
        asm volatile("s_waitcnt lgkmcnt(0)" ::: "memory");
        const int tg = lane & 7, cl = lane >> 3;
#pragma unroll
        for (int i = 0; i < 8; ++i) { const int col = cl + 8 * i; const LAS bf16_t* s = (const LAS bf16_t*)(scr + (tg * 8) * 132 + col * 2);
            u32x4 o; o.x = (unsigned)s[0] | ((unsigned)s[66] << 16); o.y = (unsigned)s[2 * 66] | ((unsigned)s[3 * 66] << 16); o.z = (unsigned)s[4 * 66] | ((unsigned)s[5 * 66] << 16); o.w = (unsigned)s[6 * 66] | ((unsigned)s[7 * 66] << 16);
            if (cb < 16) { const int dd = (cb & 3) * 64 + col, j0 = (tok0 & 127) + 8 * tg;
                const int frag = (((((tok0 >> 7) * 4 + (cb >> 2)) * 8 + (dd >> 5)) * 2 + ((dd >> 2) & 1)) * 4 + (j0 >> 5)) * 64 + ((j0 >> 3) & 3) * 16 + ((((dd >> 3) & 3) << 2) | (dd & 3));
                *(u32x4*)((bf16_t*)(c.ws + WS_KT) + (size_t)frag * 8) = o; }
            else *(u32x4*)(dst + (size_t)col * T + tok0 + tg * 8) = o; }
        asm volatile("s_waitcnt lgkmcnt(0)" ::: "memory");
        if (more) {
#pragma unroll
            for (int i = 0; i < 8; ++i) cur[i] = nxt[i]; }
    }
#undef TR_LOAD
}
#define MFMA16(a, b, c) __builtin_amdgcn_mfma_f32_16x16x32_bf16((a), (b), (c), 0, 0, 0)
__device__ __forceinline__ size_t sbuf_index(int slot, int h, int dir) {
    return slot >= 32 ? (size_t)(((slot - 32) * 4 + h) * 2 + dir) : (size_t)(512 + (((slot >> 1) * 4 + h) * 2 + dir));
}
#define R1_LOADA(dst, chunk_tok0) do { _Pragma("unroll") for (int md_ = 0; md_ < 2; ++md_) _Pragma("unroll") for (int ks_ = 0; ks_ < 4; ++ks_) \
    dst[md_][ks_] = *(const bf16x8*)(KTg + ((size_t)((((((chunk_tok0) >> 7) * 4 + h) * 8 + w) * 2 + md_) * 4 + ks_) * 64 + lane) * 8); } while (0)
#define R1_LOADV(dst, chunk_tok0) do { _Pragma("unroll") for (int i_ = 0; i_ < 2; ++i_) { const int pc_ = tid + 512 * i_; \
    dst[i_] = *(const u32x4*)(VTg + (size_t)(h * 512 + 64 * es + (pc_ >> 4)) * T + (chunk_tok0) + (pc_ & 15) * 8); } } while (0)
#define R1_WRITEV(src, buf) do { _Pragma("unroll") for (int i_ = 0; i_ < 2; ++i_) { const int pc_ = tid + 512 * i_, r_ = pc_ >> 4, cj_ = pc_ & 15; const u32x4 v_ = src[i_]; \
    const LAS float* z_ = zl + (dir ? cj_ * 8 : 127 - cj_ * 8); const int zs_ = dir ? 1 : -1; u32x4 o_; \
    o_.x = cvt_pk_bf16(bf2f(v_.x & 0xffffu) * z_[0], bf2f(v_.x >> 16) * z_[zs_]); o_.y = cvt_pk_bf16(bf2f(v_.y & 0xffffu) * z_[2 * zs_], bf2f(v_.y >> 16) * z_[3 * zs_]); \
    o_.z = cvt_pk_bf16(bf2f(v_.z & 0xffffu) * z_[4 * zs_], bf2f(v_.z >> 16) * z_[5 * zs_]); o_.w = cvt_pk_bf16(bf2f(v_.w & 0xffffu) * z_[6 * zs_], bf2f(v_.w >> 16) * z_[7 * zs_]); \
    *(LAS u32x4*)(vT + (buf) * 17408 + r_ * 272 + cj_ * 16) = o_; } } while (0)
#ifndef R1_STORE_REP
#define R1_STORE_REP 1
#endif
#define R1_STEP(ci_, Acur) do { const int ci = (ci_); const int ch = dir ? nch - 1 - ci : ci, slot = slot_base + ch; \
    __syncthreads(); \
    if (lat || ci == 1) { bf16_t* so = sb + sbuf_index(slot, h, dir) * 131072; \
        _Pragma("unroll") for (int ne = 0; ne < 4; ++ne) { u32x4 o; o.x = cvt_pk_bf16(acc[0][ne][0], acc[0][ne][1]); o.y = cvt_pk_bf16(acc[0][ne][2], acc[0][ne][3]); o.z = cvt_pk_bf16(acc[1][ne][0], acc[1][ne][1]); o.w = cvt_pk_bf16(acc[1][ne][2], acc[1][ne][3]); \
            __builtin_nontemporal_store(o, (u32x4*)(so + ((size_t)((es * 8 + w) * 4 + ne) * 64 + lane) * 8)); } } \
    if (ci + 1 < nch) R1_WRITEV(vraw, (ci + 1) & 1); \
    if (ci + 2 < nch) { const int ch2 = dir ? nch - 3 - ci : ci + 2; R1_LOADV(vraw, tok_base + ch2 * 128); } \
    _Pragma("unroll") for (int md = 0; md < 2; ++md) _Pragma("unroll") for (int ne = 0; ne < 4; ++ne) acc[md][ne] = acc[md][ne] * gC; \
    _Pragma("unroll") for (int ks = 0; ks < 4; ++ks) { bf16x8 b[4]; \
        _Pragma("unroll") for (int ne = 0; ne < 4; ++ne) b[ne] = *(const LAS bf16x8*)(vT + (ci & 1) * 17408 + (16 * ne + fr) * 272 + ks * 64 + fq * 16); \
        _Pragma("unroll") for (int md = 0; md < 2; ++md) _Pragma("unroll") for (int ne = 0; ne < 4; ++ne) acc[md][ne] = MFMA16(Acur[md][ks], b[ne], acc[md][ne]); } \
    if (ci + 2 < nch) { const int ch2 = dir ? nch - 3 - ci : ci + 2; R1_LOADA(Acur, tok_base + ch2 * 128); } } while (0)
__device__ __forceinline__ void phase_r1(const Ctx& c, int jr) {
    LAS unsigned char* vT = c.lds;
    LAS float* zl = (LAS float*)(c.lds + 2 * 17408);
    const bf16_t* KTg = (const bf16_t*)(c.ws + WS_KT); const bf16_t* VTg = (const bf16_t*)(c.ws + WS_VT);
    bf16_t* sb = (bf16_t*)(c.ws + WS_SBUF); const float* pwt = (const float*)(c.ws + WS_TAB + TAB_POW);
    const int tid = c.tid, w = c.wave, lane = c.lane, fr = lane & 15, fq = lane >> 4;
    const int nb = c.G, half = nb / 2; const bool lat = c.bid < half;
    const int ntask = lat ? 128 : 1024;
#ifndef R1_CTX_BLOCKS
#define R1_CTX_BLOCKS (nb - half)
#endif
    int bb = lat ? c.bid : c.bid - half; const int nbl = lat ? half : R1_CTX_BLOCKS;
    for (int tq = (lat || bb < nbl) ? bb : ntask; tq < ntask; tq += nbl) {
        int tk = tq;
        if (nbl == 128) { const int x = bb & 7, r = bb >> 3; tk = lat ? ((x * 2 + (r >> 3)) * 8 + (r & 7)) : (((r * 8 + x) * 8) + (tq >> 7)); }
        const int es = tk & 7, dir = (tk >> 3) & 1, h = (tk >> 4) & 3, s = tk >> 6;
        const int nch = lat ? 32 : 2, tok_base = lat ? T_CTX + s * 4096 : s * 256, slot_base = lat ? 32 + s * 32 : s * 2;
        const float* pw = pwt + ((jr * 2 + dir) * 4 + h) * 132; const float gC = pw[128];
        f32x4 acc[2][4];
#pragma unroll
        for (int md = 0; md < 2; ++md)
#pragma unroll
            for (int ne = 0; ne < 4; ++ne) {
                if (lat) { const float* sp = inp(c, I_STATE) + ((size_t)(((s * 2 + jr) * 2 + dir) * 4 + h) * 256 + 32 * w + 8 * fq + 4 * md) * 512 + 64 * es + 16 * ne + fr;
                    acc[md][ne] = (f32x4){sp[0], sp[512], sp[1024], sp[1536]}; }
                else acc[md][ne] = (f32x4){0.f, 0.f, 0.f, 0.f}; }
        bf16x8 A0[2][4], A1[2][4]; u32x4 vraw[2];
        { const int c0 = dir ? nch - 1 : 0, c1 = dir ? nch - 2 : 1;
          __syncthreads();
          if (tid < 132) zl[tid] = pw[tid];
          R1_LOADV(vraw, tok_base + c0 * 128); R1_LOADA(A0, tok_base + c0 * 128);
          __syncthreads();
          R1_WRITEV(vraw, 0);
          R1_LOADV(vraw, tok_base + c1 * 128); R1_LOADA(A1, tok_base + c1 * 128); }
        for (int ci2 = 0; ci2 < nch; ci2 += 2) { R1_STEP(ci2, A0); R1_STEP(ci2 + 1, A1); }
        if (!lat) { float* op = c.out + (size_t)T * 1024 + ((size_t)(((s * 2 + jr) * 2 + dir) * 4 + h) * 256 + 32 * w + 8 * fq) * 512 + 64 * es + fr;
#pragma unroll
            for (int md = 0; md < 2; ++md)
#pragma unroll
                for (int ne = 0; ne < 4; ++ne)
#pragma unroll
                    for (int r = 0; r < 4; ++r) __builtin_nontemporal_store(acc[md][ne][r], op + (size_t)(4 * md + r) * 512 + 16 * ne); }
    }
}
__device__ __forceinline__ void phase_r2(const Ctx& c, int jr) {
    LAS unsigned char* lds = c.lds;
    LAS unsigned char* Pm = lds;
    LAS unsigned char* Ab = lds + 34816;
    LAS unsigned char* Bb = lds + 34816 + 2 * 18432;
    LAS float* pwl = (LAS float*)(lds + 34816 + 2 * 18432 + 2 * 36864);
    const bf16_t* Qg = (const bf16_t*)(c.ws + WS_Q); const bf16_t* Kg = (const bf16_t*)(c.ws + WS_K); const bf16_t* VTg = (const bf16_t*)(c.ws + WS_VT);
    const bf16_t* sb = (const bf16_t*)(c.ws + WS_SBUF); const float* pwt = (const float*)(c.ws + WS_TAB + TAB_POW); bf16_t* Og = (bf16_t*)(c.ws + WS_O);
    const int tid = c.tid, w = c.wave, lane = c.lane, fr = lane & 15, fq = lane >> 4, wi = w >> 2, wj = w & 3;
    for (int task0 = c.bid; task0 < 768; task0 += c.G) {
        int task = task0;
        if (c.G == 256) task = ((((task0 >> 8) * 128) + ((c.bid >> 4) << 3 | (c.bid & 7))) << 1) | ((c.bid >> 3) & 1);
        const int eh = task & 1, h = (task >> 1) & 3, slot = task >> 3, tok0 = slot * 128;
        const bool lat = slot >= 32; const bool has_f = lat || (slot & 1) == 1, has_b = lat || (slot & 1) == 0;
        const bf16_t* qrow = Qg + (size_t)tok0 * 1024 + h * 256; const bf16_t* krow = Kg + (size_t)tok0 * 1024 + h * 256;
        const bf16_t* vrow = VTg + (size_t)(h * 512 + eh * 256) * T + tok0;
        const bf16_t* sgf = sb + sbuf_index(slot, h, 0) * 131072; const bf16_t* sgb = sb + sbuf_index(slot, h, 1) * 131072;
        u32x4 RA[6], RB[6];
        const int r16 = tid >> 3, c16 = tid & 7, l16 = r16 * 144 + c16 * 16;
        const int ln = tid & 63, wq = tid >> 6;
        const int soff = ((((4 * eh + (wq >> 3)) * 8 + (wq & 1)) * 4 + ((wq >> 1) & 3)) * 64 + ln) * 8;
        const int NT = 6 + (has_f ? 4 : 0) + (has_b ? 4 : 0);
#define R2_TILE(n) ((n) < 6 ? (n) : (has_f ? (n) : (n) + 4))
#define R2_LOAD_P(t_, R) do { _Pragma("unroll") for (int i = 0; i < 2; ++i) { R[i] = *(const u32x4*)(qrow + (size_t)(r16 + 64 * i) * 1024 + (t_) * 64 + c16 * 8); R[2 + i] = *(const u32x4*)(krow + (size_t)(r16 + 64 * i) * 1024 + (t_) * 64 + c16 * 8); } } while (0)
#define R2_LOAD_V(t_, R) do { _Pragma("unroll") for (int i = 0; i < 4; ++i) R[i] = *(const u32x4*)(vrow + (size_t)(r16 + 64 * i) * T + ((t_) - 4) * 64 + c16 * 8); } while (0)
#define R2_LOAD_S(tile, R) do { const int t_ = (tile); const int kd = (t_ - 6) & 3; const bf16_t* sg = (t_ >= 10 ? sgb : sgf) + soff + (size_t)kd * 4096; \
        _Pragma("unroll") for (int i = 0; i < 4; ++i) R[i] = *(const u32x4*)(sg + (size_t)i * 16384); \
        _Pragma("unroll") for (int i = 0; i < 2; ++i) R[4 + i] = *(const u32x4*)(qrow + (size_t)(r16 + 64 * i) * 1024 + kd * 64 + c16 * 8); } while (0)
#define R2_WRITE_P(R, buf) do { LAS unsigned char* A_ = Ab + (buf) * 18432; LAS unsigned char* B_ = Bb + (buf) * 36864; \
        _Pragma("unroll") for (int i = 0; i < 2; ++i) { *(LAS u32x4*)(A_ + l16 + i * 64 * 144) = R[i]; *(LAS u32x4*)(B_ + l16 + i * 64 * 144) = R[2 + i]; } } while (0)
#define R2_WRITE_V(R, buf) do { LAS unsigned char* B_ = Bb + (buf) * 36864; _Pragma("unroll") for (int i = 0; i < 4; ++i) *(LAS u32x4*)(B_ + l16 + i * 64 * 144) = R[i]; } while (0)
#define R2_WRITE_S(tile, R, buf) do { const int t_ = (tile); LAS unsigned char* A_ = Ab + (buf) * 18432; LAS unsigned char* B_ = Bb + (buf) * 36864; \
        _Pragma("unroll") for (int i = 0; i < 4; ++i) *(LAS u32x4*)(B_ + (wq + 8 * i) * 1024 + ln * 16) = R[i]; \
        _Pragma("unroll") for (int i = 0; i < 2; ++i) { const u32x4 v = R[4 + i]; \
            const float xi = t_ >= 10 ? pwl[132 + 128 - (r16 + 64 * i)] : pwl[r16 + 64 * i + 1]; u32x4 o; \
            o.x = cvt_pk_bf16(bf2f(v.x & 0xffffu) * xi, bf2f(v.x >> 16) * xi); o.y = cvt_pk_bf16(bf2f(v.y & 0xffffu) * xi, bf2f(v.y >> 16) * xi); \
            o.z = cvt_pk_bf16(bf2f(v.z & 0xffffu) * xi, bf2f(v.z >> 16) * xi); o.w = cvt_pk_bf16(bf2f(v.w & 0xffffu) * xi, bf2f(v.w >> 16) * xi); \
            *(LAS u32x4*)(A_ + l16 + i * 64 * 144) = o; } } while (0)
#define R2_MMA_P(cur) do { LAS unsigned char* A_ = Ab + (cur) * 18432; LAS unsigned char* B_ = Bb + (cur) * 36864; \
    _Pragma("unroll") for (int kk = 0; kk < 2; ++kk) { bf16x8 a[2], b[4]; \
        _Pragma("unroll") for (int mj = 0; mj < 2; ++mj) a[mj] = *(const LAS bf16x8*)(B_ + (32 * wj + 16 * mj + fr) * 144 + kk * 64 + fq * 16); \
        _Pragma("unroll") for (int ni = 0; ni < 4; ++ni) b[ni] = *(const LAS bf16x8*)(A_ + (64 * wi + 16 * ni + fr) * 144 + kk * 64 + fq * 16); \
        _Pragma("unroll") for (int mj = 0; mj < 2; ++mj) _Pragma("unroll") for (int ni = 0; ni < 4; ++ni) pacc[mj][ni] = MFMA16(a[mj], b[ni], pacc[mj][ni]); } } while (0)
#define R2_MMA_OS(cur, bptr, bstride) do { LAS unsigned char* B_ = Bb + (cur) * 36864; \
    _Pragma("unroll") for (int kk = 0; kk < 2; ++kk) { bf16x8 b[4]; \
        _Pragma("unroll") for (int ni = 0; ni < 4; ++ni) b[ni] = *(const LAS bf16x8*)((bptr) + (64 * wi + 16 * ni + fr) * (bstride) + kk * 64 + fq * 16); \
        _Pragma("unroll") for (int me = 0; me < 4; me += 2) { const bf16x8 a0 = *(const LAS bf16x8*)(B_ + ((4 * wj + me) * 2 + kk) * 1024 + lane * 16), a1 = *(const LAS bf16x8*)(B_ + ((4 * wj + me + 1) * 2 + kk) * 1024 + lane * 16); \
            _Pragma("unroll") for (int ni = 0; ni < 4; ++ni) oacc[me][ni] = MFMA16(a0, b[ni], oacc[me][ni]); \
            _Pragma("unroll") for (int ni = 0; ni < 4; ++ni) oacc[me + 1][ni] = MFMA16(a1, b[ni], oacc[me + 1][ni]); } } } while (0)
#define R2_MMA_O(cur, bptr, bstride) do { LAS unsigned char* B_ = Bb + (cur) * 36864; \
    _Pragma("unroll") for (int kk = 0; kk < 2; ++kk) { bf16x8 b[4]; \
        _Pragma("unroll") for (int ni = 0; ni < 4; ++ni) b[ni] = *(const LAS bf16x8*)((bptr) + (64 * wi + 16 * ni + fr) * (bstride) + kk * 64 + fq * 16); \
        _Pragma("unroll") for (int me = 0; me < 4; me += 2) { const bf16x8 a0 = *(const LAS bf16x8*)(B_ + (64 * wj + 16 * me + fr) * 144 + kk * 64 + fq * 16), a1 = *(const LAS bf16x8*)(B_ + (64 * wj + 16 * me + 16 + fr) * 144 + kk * 64 + fq * 16); \
            _Pragma("unroll") for (int ni = 0; ni < 4; ++ni) oacc[me][ni] = MFMA16(a0, b[ni], oacc[me][ni]); \
            _Pragma("unroll") for (int ni = 0; ni < 4; ++ni) oacc[me + 1][ni] = MFMA16(a1, b[ni], oacc[me + 1][ni]); } } } while (0)
        __syncthreads();
        { int t2 = tid; asm volatile("" : "+v"(t2));
          if (t2 < 264) { const int dd = t2 >= 132 ? 1 : 0, n = t2 - dd * 132; pwl[t2] = pwt[((jr * 2 + dd) * 4 + h) * 132 + n]; } }
        R2_LOAD_P(0, RA); R2_LOAD_P(1, RB); R2_WRITE_P(RA, 0); R2_LOAD_P(2, RA);
        __syncthreads();
        {
            f32x4 pacc[2][4];
#pragma unroll
            for (int a = 0; a < 2; ++a)
#pragma unroll
                for (int b = 0; b < 4; ++b) pacc[a][b] = (f32x4){0.f, 0.f, 0.f, 0.f};
            R2_WRITE_P(RB, 1); R2_LOAD_P(3, RB); R2_MMA_P(0); __syncthreads();
            R2_WRITE_P(RA, 0); R2_LOAD_V(4, RA); R2_MMA_P(1); __syncthreads();
            R2_WRITE_P(RB, 1); R2_LOAD_V(5, RB); R2_MMA_P(0); __syncthreads();
            R2_WRITE_V(RA, 0); if (NT > 6) R2_LOAD_S(R2_TILE(6), RA); R2_MMA_P(1);
#pragma unroll
            for (int mj = 0; mj < 2; ++mj)
#pragma unroll
                for (int ni = 0; ni < 4; ++ni) { const int i = 64 * wi + 16 * ni + fr, j0 = 32 * wj + 16 * mj + 4 * fq; float v[4];
#pragma unroll
                    for (int r = 0; r < 4; ++r) { const int df = i - (j0 + r); v[r] = pacc[mj][ni][r] * (df >= 0 ? pwl[df] : pwl[132 - df]); }
                    u32x2 o; o.x = cvt_pk_bf16(v[0], v[1]); o.y = cvt_pk_bf16(v[2], v[3]);
                    *(LAS u32x2*)(Pm + i * 272 + j0 * 2) = o; }
            __syncthreads();
        }
        f32x4 oacc[4][4];
#pragma unroll
        for (int a = 0; a < 4; ++a)
#pragma unroll
            for (int b = 0; b < 4; ++b) oacc[a][b] = (f32x4){0.f, 0.f, 0.f, 0.f};
        R2_WRITE_V(RB, 1); if (NT > 7) R2_LOAD_S(R2_TILE(7), RB); R2_MMA_O(0, Pm, 272); __syncthreads();
        if (NT > 6) R2_WRITE_S(R2_TILE(6), RA, 0); if (NT > 8) R2_LOAD_S(R2_TILE(8), RA); R2_MMA_O(1, Pm + 128, 272); __syncthreads();
        for (int n = 6; n < NT; n += 2) {
            if (n + 1 < NT) R2_WRITE_S(R2_TILE(n + 1), RB, 1); if (n + 3 < NT) R2_LOAD_S(R2_TILE(n + 3), RB); R2_MMA_OS(0, Ab, 144); __syncthreads();
            if (n + 2 < NT) R2_WRITE_S(R2_TILE(n + 2), RA, 0); if (n + 4 < NT) R2_LOAD_S(R2_TILE(n + 4), RA); R2_MMA_OS(1, Ab + 18432, 144); __syncthreads();
        }
        {
            int t3 = tid; asm volatile("" : "+v"(t3));
            LAS float* st = (LAS float*)Pm;
            LAS float* st2 = (LAS float*)(Pm + 4096);
            unsigned long long* gstats = (unsigned long long*)(c.ws + WS_MODP); unsigned* gflag = (unsigned*)(c.ws + WS_BAR + 16384);
            const unsigned epoch = (unsigned)jr + 1u;
#pragma unroll
            for (int ni = 0; ni < 4; ++ni) { float s1 = 0.f, s2 = 0.f;
#pragma unroll
                for (int me = 0; me < 4; ++me)
#pragma unroll
                    for (int r = 0; r < 4; ++r) { const float v = oacc[me][ni][r]; s1 += v; s2 += v * v; }
                s1 += __shfl_xor(s1, 16); s1 += __shfl_xor(s1, 32); s2 += __shfl_xor(s2, 16); s2 += __shfl_xor(s2, 32);
                if (fq == 0) { const int i = 64 * wi + 16 * ni + fr; st[(i * 4 + wj) * 2] = s1; st[(i * 4 + wj) * 2 + 1] = s2; } }
            __syncthreads();
            u32x2 gq[4][4]; f32x4 gnv[4];
            const bf16_t* Gg = (const bf16_t*)(c.ws + WS_G); const float* gnw = inp(c, I_GNW) + (jr * 4 + h) * 512 + eh * 256 + 64 * wj + 4 * fq;
#pragma unroll
            for (int me = 0; me < 4; ++me) { gnv[me] = *(const f32x4*)(gnw + 16 * me);
#pragma unroll
                for (int ni = 0; ni < 4; ++ni) gq[me][ni] = *(const u32x2*)(Gg + (size_t)(tok0 + 64 * wi + 16 * ni + fr) * 2048 + h * 512 + eh * 256 + 64 * wj + 16 * me + 4 * fq); }
            float p1 = 0.f, p2 = 0.f;
            if (t3 < 128) {
#pragma unroll
                for (int q = 0; q < 4; ++q) { p1 += st[(t3 * 4 + q) * 2]; p2 += st[(t3 * 4 + q) * 2 + 1]; }
                const unsigned long long pk = (unsigned long long)__builtin_bit_cast(unsigned, p1) | ((unsigned long long)__builtin_bit_cast(unsigned, p2) << 32);
                __hip_atomic_store(gstats + (size_t)task * 128 + t3, pk, __ATOMIC_RELAXED, __HIP_MEMORY_SCOPE_AGENT); }
            asm volatile("s_waitcnt vmcnt(0)" ::: "memory");
            __syncthreads();
            if (t3 == 0) {
                __hip_atomic_store(gflag + task, epoch, __ATOMIC_RELAXED, __HIP_MEMORY_SCOPE_AGENT);
                unsigned sp = 0;
                while (__hip_atomic_load(gflag + (task ^ 1), __ATOMIC_RELAXED, __HIP_MEMORY_SCOPE_AGENT) != epoch) { __builtin_amdgcn_s_sleep(2); if (++sp > (1u << 20)) break; }
                __builtin_amdgcn_fence(__ATOMIC_ACQUIRE, "agent");
                asm volatile("s_waitcnt vmcnt(0)" ::: "memory"); }
            __syncthreads();
            if (t3 < 128) {
                const unsigned long long q = __hip_atomic_load(gstats + (size_t)(task ^ 1) * 128 + t3, __ATOMIC_RELAXED, __HIP_MEMORY_SCOPE_AGENT);
                const float S1 = p1 + __builtin_bit_cast(float, (unsigned)(q & 0xffffffffull)), S2 = p2 + __builtin_bit_cast(float, (unsigned)(q >> 32));
                const float mu = S1 * (1.f / 512.f), var = fmaxf(S2 * (1.f / 512.f) - mu * mu, 0.f);
                st2[t3 * 2] = mu; st2[t3 * 2 + 1] = rsqrtf(var + GN_EPS); }
            __syncthreads();
            bf16_t* Ag = (bf16_t*)(c.ws + WS_A);
#pragma unroll
            for (int ni = 0; ni < 4; ++ni) { const int i = 64 * wi + 16 * ni + fr; const float mu = st2[i * 2], rs = st2[i * 2 + 1];
#pragma unroll
                for (int me = 0; me < 4; ++me) { const u32x2 gb = gq[me][ni];
                    const float g0 = bf2f(gb.x & 0xffffu), g1 = bf2f(gb.x >> 16), g2 = bf2f(gb.y & 0xffffu), g3 = bf2f(gb.y >> 16);
                    const f32x4 o = (oacc[me][ni] - mu) * rs * gnv[me];
                    u32x2 w; w.x = cvt_pk_bf16(silu_f(g0) * o[0], silu_f(g1) * o[1]); w.y = cvt_pk_bf16(silu_f(g2) * o[2], silu_f(g3) * o[3]);
                    *(u32x2*)(Ag + (size_t)(tok0 + i) * 2048 + h * 512 + eh * 256 + 64 * wj + 16 * me + 4 * fq) = w; } }
        }
    }
}
__device__ __forceinline__ void phase_gate(const Ctx& c, int jr) {
    const bf16_t* Og = (const bf16_t*)(c.ws + WS_O); const bf16_t* Gg = (const bf16_t*)(c.ws + WS_G); bf16_t* Ag = (bf16_t*)(c.ws + WS_A);
    const float* gnw = inp(c, I_GNW) + jr * 4 * 512;
    for (int it0 = c.gw; it0 < T * 4; it0 += 4 * c.ngw) {
        u32x2 ob[4][2], gb[4][2];
#pragma unroll
        for (int k = 0; k < 4; ++k) { const int it = min(it0 + k * c.ngw, T * 4 - 1); const size_t base = (size_t)(it >> 2) * 2048 + (it & 3) * 512;
#pragma unroll
            for (int j = 0; j < 2; ++j) { ob[k][j] = *(const u32x2*)(Og + base + 4 * c.lane + 256 * j); gb[k][j] = *(const u32x2*)(Gg + base + 4 * c.lane + 256 * j); } }
#pragma unroll
        for (int k = 0; k < 4; ++k) { const int it = it0 + k * c.ngw; if (it < T * 4) { const int h = it & 3; const size_t base = (size_t)(it >> 2) * 2048 + h * 512;
            f32x4 v[2]; float s = 0.f;
#pragma unroll
            for (int j = 0; j < 2; ++j) { v[j] = (f32x4){bf2f(ob[k][j].x & 0xffffu), bf2f(ob[k][j].x >> 16), bf2f(ob[k][j].y & 0xffffu), bf2f(ob[k][j].y >> 16)}; s += (v[j][0] + v[j][1]) + (v[j][2] + v[j][3]); }
            const float mu = wave_sum(s) * (1.f / 512.f); float q = 0.f;
#pragma unroll
            for (int j = 0; j < 2; ++j) { v[j] = v[j] - mu; q += (v[j][0] * v[j][0] + v[j][1] * v[j][1]) + (v[j][2] * v[j][2] + v[j][3] * v[j][3]); }
            const float rstd = rsqrtf(wave_sum(q) * (1.f / 512.f) + GN_EPS);
#pragma unroll
            for (int j = 0; j < 2; ++j) { const int col = 4 * c.lane + 256 * j; const f32x4 gw = *(const f32x4*)(gnw + h * 512 + col);
                const float g0 = bf2f(gb[k][j].x & 0xffffu), g1 = bf2f(gb[k][j].x >> 16), g2 = bf2f(gb[k][j].y & 0xffffu), g3 = bf2f(gb[k][j].y >> 16);
                const f32x4 o = v[j] * rstd * gw;
                u32x2 w; w.x = cvt_pk_bf16(silu_f(g0) * o[0], silu_f(g1) * o[1]); w.y = cvt_pk_bf16(silu_f(g2) * o[2], silu_f(g3) * o[3]);
                *(u32x2*)(Ag + base + col) = w; } } }
    }
}

#ifndef MULTI_LAUNCH
#define MULTI_LAUNCH 0
#endif
#define PH_ON (ph >= p.ph_lo && ph < p.ph_hi)
#define FRESH const Ctx c = fresh_ctx(&p, lds, bar.w0); unsigned char* const ws = c.ws; const int G = c.G; const float* const mod = (const float*)(ws + WS_MOD); (void)G; (void)mod
#ifndef SYNC_REP
#define SYNC_REP 1
#endif
#ifndef REP_R1
#define REP_R1 1
#endif
#ifndef REP_R2
#define REP_R2 1
#endif
#ifndef REP_LIGHT
#define REP_LIGHT 1
#endif
#ifndef REP_POOL
#define REP_POOL 1
#endif
#ifndef REP_NORM
#define REP_NORM 1
#endif
#ifndef REP_TR
#define REP_TR 1
#endif
#ifndef REP_GATE
#define REP_GATE 1
#endif
#ifndef REP_P0
#define REP_P0 1
#endif
#ifndef REP_P0C
#define REP_P0C 1
#endif
#ifndef REP_GEMM_IN
#define REP_GEMM_IN 1
#endif
#ifndef REP_GEMM_UP
#define REP_GEMM_UP 1
#endif
#ifndef REP_GEMM_DOWN
#define REP_GEMM_DOWN 1
#endif
#ifndef REP_GEMM
#define REP_GEMM 1
#endif
#define PH_END do { ++ph; if (ph > p.ph_lo && ph < p.ph_hi) { for (int r_ = 0; r_ < SYNC_REP; ++r_) xcd_barrier(bar); } } while (0)
template <class Sched> __device__ __forceinline__ void stage_rstd_bias(const Ctx& c, const Sched& S, const float* rowss, const float* bias, int ldb) {
    LAS float* tab = (LAS float*)(c.lds + 132 * 1024);
    pg8::Unit u;
    for (int i = 0; i < 8 && S.next(i, u); ++i) {
        if (c.tid < 256) { const f32x4* rp = (const f32x4*)(rowss + (size_t)(u.pm * 256 + c.tid) * 16); const f32x4 a = rp[0] + rp[1] + rp[2] + rp[3];
            tab[i * 512 + c.tid] = rsqrtf(((a[0] + a[1]) + (a[2] + a[3])) * (1.f / 1024.f) + NORM_EPS); }
        else { const int cvv = u.pm < 16 ? 0 : (u.pm < 32 ? 1 : 2); tab[i * 512 + c.tid] = bias[(size_t)cvv * ldb + u.pn * 256 + (c.tid - 256)]; }
    }
    __syncthreads();
}
template <class Sched> __device__ __forceinline__ void stage_res_vectors(const Ctx& c, const Sched& S, const float* gate, int nh, const float* nw, const float* sc) {
    LAS float* tab = (LAS float*)(c.lds + 132 * 1024);
    pg8::Unit u;
    for (int i = 0; i < 2 && S.next(i, u); ++i)
        for (int idx = c.tid; idx < 1536; idx += NTHREADS) { const int which = idx >= 768 ? 1 : 0, r = idx - which * 768, cvv = r >> 8, col = u.pn * 256 + (r & 255);
            tab[i * 1536 + idx] = which == 0 ? gate[(size_t)cvv * NMOD + col] : (nh ? nw[col] * (1.f + sc[(size_t)cvv * NMOD + col]) : 0.f); }
    __syncthreads();
}
template <int l> __device__ __forceinline__ void run_layer(const Params& p, LAS unsigned char* const lds, const XcdBarrier& bar, int& ph) {
        const int j2 = l >> 1;
        if ((l & 1) == 0) {
            if (PH_ON) { for (int r_ = 0; r_ < REP_NORM; ++r_) { FRESH; if (l == 0) bias_finalize(c); phase_norm<1>(c, l, 0, l == 0); } }
            PH_END;
            if (PH_ON) { for (int r_ = 0; r_ < REP_POOL; ++r_) { FRESH; phase_pool_v(c); } }
            PH_END;
            if (PH_ON) { for (int r_ = 0; r_ < REP_POOL; ++r_) { FRESH; phase_pool_h(c); } }
            PH_END;
            if (PH_ON) { FRESH;
                pg8::Gemm g{(const bf16_t*)(ws + WS_DBUF), (const bf16_t*)(ws + WS_PWT) + (size_t)j2 * 262144, 4 * T, 1024, 256};
                pg8::PoolOrder S{G, c.bid};
                pg8::EpiPool E{(float*)(ws + WS_X), inp(c, I_XP), inp(c, I_XS), l == 0 ? 1 : 0, mod + (size_t)(l * 3) * NMOD + 2 * 1024, inp(c, I_PB) + j2 * 1024, inp(c, I_PS) + j2 * 1024,
                                inp(c, I_NMLP) + l * 1024, mod + (size_t)(l * 3) * NMOD + 4 * 1024, (bf16_t*)(ws + WS_HB), (float*)(ws + WS_ROWSS)};
                pg8::gemm_phase<pg8::EpiPool, pg8::PoolOrder, true, true>(c.lds, g, S, E, c.tid);
            }
            PH_END;
        } else {
            if (PH_ON) { FRESH;
                pg8::Gemm g{(const bf16_t*)(ws + WS_HB), (const bf16_t*)(ws + WS_WINT) + (size_t)j2 * RIN * 1024, T, RIN, 1024};
                pg8::EpiInproj E{(bf16_t*)(ws + WS_Q), (bf16_t*)(ws + WS_K), (bf16_t*)(ws + WS_V), (bf16_t*)(ws + WS_G), (const float*)(ws + WS_TAB + TAB_ROPE), (const LAS float*)(c.lds + 132 * 1024), 0};
                if (G == 256) { pg8::InprojOrder S; S.init(G, c.bid);
                    stage_rstd_bias(c, S, (const float*)(ws + WS_ROWSS), (const float*)(ws + WS_BIASI) + (size_t)j2 * 3 * RIN, RIN);
                    pg8::gemm_phase<pg8::EpiInproj, pg8::InprojOrder, true, true>(c.lds, g, S, E, c.tid); }
                else { pg8::StaticOrder S; S.init(T, RIN, G, c.bid);
                    stage_rstd_bias(c, S, (const float*)(ws + WS_ROWSS), (const float*)(ws + WS_BIASI) + (size_t)j2 * 3 * RIN, RIN);
                    pg8::gemm_phase<pg8::EpiInproj, pg8::StaticOrder, true, true>(c.lds, g, S, E, c.tid); }
            }
            PH_END;
            if (PH_ON) { for (int r_ = 0; r_ < REP_TR; ++r_) { FRESH; phase_tr(c); } }
            PH_END;
            if (PH_ON) { for (int r_ = 0; r_ < REP_R1; ++r_) { FRESH; phase_r1(c, j2); }
                { FRESH;
                  if (G == 256 && c.bid >= 128) { const int idx = c.bid - 128;
                    __syncthreads();
                    pg8::Gemm g{(const bf16_t*)(ws + WS_HB), (const bf16_t*)(ws + WS_WINT) + (size_t)j2 * RIN * 1024, T, RIN, 1024};
                    pg8::SingleOrder S{idx & 15, 16 + (idx >> 4)};
                    pg8::EpiInproj E{(bf16_t*)(ws + WS_Q), (bf16_t*)(ws + WS_K), (bf16_t*)(ws + WS_V), (bf16_t*)(ws + WS_G), (const float*)(ws + WS_TAB + TAB_ROPE), (const LAS float*)(c.lds + 132 * 1024), 0};
                    stage_rstd_bias(c, S, (const float*)(ws + WS_ROWSS), (const float*)(ws + WS_BIASI) + (size_t)j2 * 3 * RIN, RIN);
                    pg8::gemm_phase<pg8::EpiInproj, pg8::SingleOrder, true, true>(c.lds, g, S, E, c.tid); } } }
            PH_END;
            if (PH_ON) { for (int r_ = 0; r_ < REP_R2; ++r_) { FRESH; phase_r2(c, j2); } }
            PH_END;
            if (PH_ON) { FRESH;
                pg8::Gemm g{(const bf16_t*)(ws + WS_A), (const bf16_t*)(ws + WS_WOUTT) + (size_t)j2 * 1024 * HV, T, 1024, HV};
                pg8::StaticOrder S; S.init(T, 1024, G, c.bid); S.nM = T / 192; S.nwg = S.nM * S.nN;
                pg8::EpiRes192 E{(float*)(ws + WS_X), 1, (bf16_t*)(ws + WS_HB), (float*)(ws + WS_ROWSS), (const LAS float*)(c.lds + 132 * 1024), 0};
                stage_res_vectors(c, S, mod + (size_t)(l * 3) * NMOD + 2 * 1024, 1, inp(c, I_NMLP) + l * 1024, mod + (size_t)(l * 3) * NMOD + 4 * 1024);
                pg8::gemm_phase<pg8::EpiRes192, pg8::StaticOrder, true, true, 3>(c.lds, g, S, E, c.tid);
            }
            PH_END;
        }
        if (PH_ON) { FRESH;
            pg8::Gemm g{(const bf16_t*)(ws + WS_HB), (const bf16_t*)(ws + WS_W1T) + (size_t)l * 4096 * 1024, T, FF, 1024};
            pg8::StaticOrder S; S.init(T, FF, G, c.bid);
            pg8::EpiUp E{(bf16_t*)(ws + WS_H), (const LAS float*)(c.lds + 132 * 1024), 0};
            stage_rstd_bias(c, S, (const float*)(ws + WS_ROWSS), (const float*)(ws + WS_BIASU) + (size_t)l * 3 * 4096, 4096);
            for (int r_ = 0; r_ < REP_GEMM_UP; ++r_) { E.ord = 0; pg8::gemm_phase<pg8::EpiUp, pg8::StaticOrder, true, true>(c.lds, g, S, E, c.tid); }
        }
        PH_END;
        if (PH_ON) { FRESH;
            pg8::Gemm g{(const bf16_t*)(ws + WS_H), (const bf16_t*)(ws + WS_W2T) + (size_t)l * 1024 * 4096, T, 1024, FF};
            pg8::StaticOrder S; S.init(T, 1024, G, c.bid); S.nM = T / 192; S.nwg = S.nM * S.nN;
            pg8::EpiRes192 E{(float*)(ws + WS_X), (l & 1) == 0 ? 1 : 0, (bf16_t*)(ws + WS_HB), (float*)(ws + WS_ROWSS), (const LAS float*)(c.lds + 132 * 1024), 0};
            stage_res_vectors(c, S, mod + (size_t)(l * 3) * NMOD + 5 * 1024, (l & 1) == 0 ? 1 : 0, inp(c, I_NMIX) + ((l + 1) & 3) * 1024, mod + (size_t)(((l + 1) & 3) * 3) * NMOD + 1 * 1024);
            for (int r_ = 1; r_ < REP_GEMM_DOWN; ++r_) { pg8::EpiRes192 E2{(float*)(ws + WS_O), 0, (bf16_t*)(ws + WS_HB), (float*)(ws + WS_ROWSS), (const LAS float*)(c.lds + 132 * 1024), 0}; pg8::gemm_phase<pg8::EpiRes192, pg8::StaticOrder, true, true, 3>(c.lds, g, S, E2, c.tid); }
            pg8::gemm_phase<pg8::EpiRes192, pg8::StaticOrder, true, true, 3>(c.lds, g, S, E, c.tid);
        }
        PH_END;
    }
constexpr int N_PHASES = 3 + 2 * 6 + 2 * 7 + 1;
__global__ void __launch_bounds__(NTHREADS) fwd_megakernel(Params p) {
    extern __shared__ __attribute__((aligned(16))) unsigned char lds_raw[];
    cg::grid_group grid = cg::this_grid();
    LAS unsigned char* const lds = (LAS unsigned char*)lds_raw;
    if (p.ph_hi < 0) grid.sync();
    volatile LAS unsigned* const bst = (volatile LAS unsigned*)(lds + LDS_BAR_OFF);
    if (threadIdx.x < 4) bst[threadIdx.x] = 0u;
    __syncthreads();
    XcdBarrier bar = xcd_barrier_post((unsigned*)(p.ws + WS_BAR), bst);
    bar.w0 = __builtin_amdgcn_readfirstlane((int)threadIdx.x >> 6);
    int ph = 0;
    if (PH_ON) { for (int r_ = 0; r_ < REP_P0; ++r_) { FRESH; phase_p0(c); } }
    PH_END;
    if (PH_ON) { FRESH; phase_p0b(c); }
    PH_END;
    if (PH_ON) { for (int r_ = 0; r_ < REP_P0C; ++r_) { FRESH; phase_p0c(c); } }
    PH_END;
    run_layer<0>(p, lds, bar, ph); run_layer<1>(p, lds, bar, ph); run_layer<2>(p, lds, bar, ph); run_layer<3>(p, lds, bar, ph);
    if (PH_ON) { FRESH; phase_norm<2>(c, 0, 0, 0); }
}

extern "C" void kernel_launch(void* const* d_in, const int* in_sizes, int n_in, void* d_out, int out_size, void* d_ws, size_t ws_size, hipStream_t stream) {
    static int grid = 0;
    if (grid == 0) {
        if (n_in != 19 || ws_size < WS_END) { fprintf(stderr, "kernel_launch: unexpected n_in %d / ws_size %zu\n", n_in, ws_size); grid = -1; return; }
        int dev = 0, cus = 0, per_cu = 0;
        hipGetDevice(&dev); hipDeviceGetAttribute(&cus, hipDeviceAttributeMultiprocessorCount, dev);
        if (hipFuncSetAttribute((const void*)fwd_megakernel, hipFuncAttributeMaxDynamicSharedMemorySize, LDS_BYTES) != hipSuccess) { fprintf(stderr, "kernel_launch: hipFuncSetAttribute failed\n"); grid = -1; return; }
        if (hipOccupancyMaxActiveBlocksPerMultiprocessor(&per_cu, (const void*)fwd_megakernel, NTHREADS, LDS_BYTES) != hipSuccess || per_cu < 1) { fprintf(stderr, "kernel_launch: occupancy query says %d\n", per_cu); per_cu = 1; }
        (void)hipGetLastError();
        grid = cus;
    }
    if (grid < 0) return;
    if (hipMemsetAsync((char*)d_ws + WS_BAR, 0, 16384 + 4096, stream) != hipSuccess) { fprintf(stderr, "kernel_launch: memset of barrier words failed\n"); return; }
    Params p{};
    for (int i = 0; i < 19; ++i) p.in[i] = (const float*)d_in[i];
    p.out = (float*)d_out; p.ws = (unsigned char*)d_ws;
#if MULTI_LAUNCH
    for (int k = 0; k < N_PHASES; ++k) { p.ph_lo = k; p.ph_hi = k + 1; hipLaunchKernelGGL(fwd_megakernel, dim3(grid), dim3(NTHREADS), LDS_BYTES, stream, p); }
#else
    p.ph_lo = 0; p.ph_hi = N_PHASES;
    void* args[] = {&p};
    hipError_t e = hipLaunchCooperativeKernel((const void*)fwd_megakernel, dim3(grid), dim3(NTHREADS), args, LDS_BYTES, stream);
    if (e != hipSuccess) fprintf(stderr, "kernel_launch: cooperative launch failed: %s (grid %d)\n", hipGetErrorString(e), grid);
#endif
}
```

```cpp
#include <hip/hip_runtime.h>
#include <hip/hip_cooperative_groups.h>
#include <cstdio>
#include <cstdint>
namespace cg = cooperative_groups;

#define LAS __attribute__((address_space(3)))
typedef unsigned short bf16_t;
typedef short bf16x8 __attribute__((ext_vector_type(8)));
typedef float f32x4 __attribute__((ext_vector_type(4)));
typedef float f32x2 __attribute__((ext_vector_type(2)));
typedef unsigned u32x4 __attribute__((ext_vector_type(4)));
typedef unsigned u32x2 __attribute__((ext_vector_type(2)));

constexpr int D = 1024, FF = 4096, T_CTX = 4096, T = 12288, RIN = 6144, HV = 2048, NMOD = 6144;
constexpr float NORM_EPS = 1e-6f, GN_EPS = 1e-5f;
constexpr int NWAVES = 8, NTHREADS = 512;
constexpr size_t MiB = 1u << 20;
constexpr size_t WS_W1T = 0, WS_W2T = 32 * MiB, WS_WINT = 64 * MiB, WS_WOUTT = 88 * MiB, WS_PWT = 96 * MiB, WS_MODP = 97 * MiB, WS_MOD = 102 * MiB,
                 WS_TAB = 103 * MiB, WS_X = 104 * MiB, WS_HB = 152 * MiB, WS_Q = 176 * MiB, WS_K = 200 * MiB, WS_V = 224 * MiB, WS_G = 272 * MiB,
                 WS_O = 320 * MiB, WS_VT = 416 * MiB, WS_SBUF = 464 * MiB, WS_END = 624 * MiB;
constexpr size_t WS_KT = WS_O + 48 * MiB  , WS_DBUF = WS_G, WS_A = WS_O, WS_HF32 = WS_O, WS_VS = WS_O + 48 * MiB, WS_H = WS_SBUF;
constexpr size_t WS_BAR = WS_MOD + 512 * 1024;
constexpr size_t WS_ROWSS = WS_TAB + 128 * 1024;
constexpr size_t WS_BIASP = WS_VS, WS_BIASU = WS_MOD + 528 * 1024, WS_BIASI = WS_BIASU + 4 * 3 * 4096 * 4;
constexpr size_t TAB_ROPE = 0, TAB_POW = 65536;
constexpr int LDS_BYTES = 151 * 1024, LDS_BAR_OFF = 150 * 1024;

struct Params { const float* in[19]; float* out; unsigned char* ws; int ph_lo, ph_hi; };
enum { I_XP = 0, I_XS, I_STATE, I_C, I_CCTX, I_WADA, I_BADA, I_NMIX, I_NMLP, I_PW, I_PB, I_PS, I_WIN, I_DECAY, I_GNW, I_WOUT, I_W1, I_W2, I_FNW };

__device__ __forceinline__ int tid_from_wave(int wave0) { return wave0 * 64 + (int)__builtin_amdgcn_mbcnt_hi(~0u, __builtin_amdgcn_mbcnt_lo(~0u, 0u)); }
__device__ __forceinline__ float bf2f(unsigned h) { return __builtin_bit_cast(float, h << 16); }
__device__ __forceinline__ unsigned cvt_pk_bf16(float lo, float hi) { unsigned r; asm volatile("v_cvt_pk_bf16_f32 %0, %1, %2" : "=v"(r) : "v"(lo), "v"(hi)); return r; }
__device__ __forceinline__ float wave_sum(float v) {
#pragma unroll
    for (int o = 1; o < 64; o <<= 1) v += __shfl_xor(v, o);
    return v;
}
__device__ __forceinline__ float silu_f(float v) { return v / (1.f + __expf(-v)); }
__device__ __forceinline__ int perm8(int L) { return (L & ~31) | (((L >> 2) & 1) << 4) | (((L >> 3) & 3) << 2) | (L & 3); }
__device__ __forceinline__ int permrope(int L) { return (L & ~127) | (((L >> 4) & 3) << 5) | (((L >> 6) & 1) << 4) | (L & 15); }
__device__ __forceinline__ int cv_of_row(int row) { return row < T_CTX ? 0 : 1 + ((row - T_CTX) >> 12); }

namespace pg8 {
#define PG8_LAS __attribute__((address_space(3)))
typedef unsigned short bf16_t;
typedef short bf16x8 __attribute__((ext_vector_type(8)));
typedef float f32x4 __attribute__((ext_vector_type(4)));
typedef unsigned u32x4 __attribute__((ext_vector_type(4)));
constexpr int BM = 256, BK = 64, HALF = 128, HTB = HALF * BK * 2  , STAGE_BYTES = 8 * HTB, NXCD = 8, WGM = 8;

__host__ __device__ __forceinline__ int lds_byte(int r, int c) { const int st = (r >> 4) * 2 + (c >> 5), rr = r & 15, cc = c & 31, ob = rr * 64 + cc * 2; return st * 1024 + (ob ^ (((ob >> 9) & 1) << 5)); }
__host__ __device__ __forceinline__ void stage_rc(int b, int& R, int& C) { const int st = b / 1024, sb = b % 1024, swz = sb ^ (((sb >> 9) & 1) << 5); R = (st >> 1) * 16 + swz / 64; C = (st & 1) * 32 + (swz % 64) / 2; }
__host__ __device__ __forceinline__ int perm32(int rho) { const int n = rho >> 4, i = rho & 15; return 8 * (i >> 2) + 4 * n + (i & 3); }

struct Unit { int pm, pn; };
struct Gemm { const bf16_t* A; const bf16_t* Bt; int M, N, K; };

struct StaticOrder {
    int nM, nN, nwg, G, c;
    __host__ __device__ void init(int M, int N, int G_, int c_) { nM = M / BM; nN = N / BM; nwg = nM * nN; G = G_; c = c_; }
    __host__ __device__ bool next(int i, Unit& u) const {
        const long L = (long)i * G + c; if (L >= nwg) return false;
        int wgid = (int)L; { const int q = nwg / NXCD, r = nwg % NXCD, xcd = wgid % NXCD, off = wgid / NXCD; wgid = (xcd < r ? xcd * (q + 1) : r * (q + 1) + (xcd - r) * q) + off; }
        const int nig = WGM * nN, gid = wgid / nig, fm = gid * WGM, gsz = (nM - fm) < WGM ? (nM - fm) : WGM;
        u.pm = fm + ((wgid % nig) % gsz); u.pn = (wgid % nig) / gsz; return true;
    }
    __device__ __forceinline__ void a_ready(const Unit&) const {}
    __device__ __forceinline__ void done(const Unit&) const {}
};

__device__ __forceinline__ unsigned cvt_pk_bf16(float lo, float hi) { unsigned r; asm volatile("v_cvt_pk_bf16_f32 %0, %1, %2" : "=v"(r) : "v"(lo), "v"(hi)); return r; }

struct PoolOrder {
    int G, c;
    __device__ bool next(int i, Unit& u) const { const long L = (long)i * G + c; if (L >= 192) return false; u.pm = (int)L; u.pn = (int)L / 48; return true; }
    __device__ __forceinline__ void a_ready(const Unit&) const {}
    __device__ __forceinline__ void done(const Unit&) const {}
};
struct InprojOrder {
    StaticOrder L, C; int G, c;
    __device__ void init(int G_, int c_) { G = G_; c = c_; L.init(8192, 6144, G_, c_); C.init(4096, 4096, G_, c_); }
    __device__ bool next(int i, Unit& u) const { const long id = (long)i * G + c; if (id >= 1024) return false;
        if (id < 768) { StaticOrder t = L; t.c = (int)(id % G); if (!t.next((int)(id / G), u)) return false; u.pm += 16; return true; }
        const long k = id - 768; StaticOrder t = C; t.c = (int)(k % G); return t.next((int)(k / G), u); }
    __device__ __forceinline__ void a_ready(const Unit&) const {}
    __device__ __forceinline__ void done(const Unit&) const {}
};
struct SingleOrder { int pm, pn;
    __device__ bool next(int i, Unit& u) const { if (i > 0) return false; u.pm = pm; u.pn = pn; return true; }
    __device__ __forceinline__ void a_ready(const Unit&) const {}
    __device__ __forceinline__ void done(const Unit&) const {}
};
struct EpiUp {
    static constexpr bool PERM = false, AFTER_DRAIN = false;
    bf16_t* H; const PG8_LAS float* tab; mutable int ord;
    __device__ __forceinline__ void operator()(const f32x4 (&acc)[2][2][4][2], const Unit& u, int wr, int wc, int fr, int fq) const {
        const int row0 = u.pm * BM + wr * 64 + fr, col0 = u.pn * BM + wc * 32 + 8 * fq;
        const PG8_LAS float* rt = tab + ord * 512 + wr * 64 + fr; const PG8_LAS float* bt = tab + ord * 512 + 256 + wc * 32 + 8 * fq; ++ord;
#pragma unroll
        for (int bj = 0; bj < 2; ++bj) { const f32x4 b0 = *(const PG8_LAS f32x4*)(bt + bj * HALF), b1 = *(const PG8_LAS f32x4*)(bt + bj * HALF + 4);
#pragma unroll
            for (int ai = 0; ai < 2; ++ai)
#pragma unroll
                for (int m = 0; m < 4; ++m) { const float rs = rt[ai * HALF + m * 16]; f32x4 v0 = acc[ai][bj][m][0] * rs + b0, v1 = acc[ai][bj][m][1] * rs + b1;
#pragma unroll
                    for (int j = 0; j < 4; ++j) { const float a = fmaxf(v0[j], 0.f), b = fmaxf(v1[j], 0.f); v0[j] = a * a; v1[j] = b * b; }
                    u32x4 w; w.x = cvt_pk_bf16(v0[0], v0[1]); w.y = cvt_pk_bf16(v0[2], v0[3]); w.z = cvt_pk_bf16(v1[0], v1[1]); w.w = cvt_pk_bf16(v1[2], v1[3]);
                    *(u32x4*)(H + (size_t)(row0 + ai * HALF + m * 16) * 4096 + col0 + bj * HALF) = w; } }
    }
};
struct EpiRes {
    static constexpr bool PERM = false, AFTER_DRAIN = false;
    float* X; const float* gate;
    __device__ __forceinline__ void operator()(const f32x4 (&acc)[2][2][4][2], const Unit& u, int wr, int wc, int fr, int fq) const {
        const int row0 = u.pm * BM + wr * 64 + fr, col0 = u.pn * BM + wc * 32 + 8 * fq;
        const int cv = u.pm < 16 ? 0 : (u.pm < 32 ? 1 : 2);
#pragma unroll
        for (int bj = 0; bj < 2; ++bj)
#pragma unroll
            for (int n = 0; n < 2; ++n) {
                const int co = col0 + bj * HALF + 4 * n;
                const f32x4 gv = *(const f32x4*)(gate + cv * 6144 + co);
#pragma unroll
                for (int ai = 0; ai < 2; ++ai)
#pragma unroll
                    for (int m = 0; m < 4; ++m) { f32x4* px = (f32x4*)(X + (size_t)(row0 + ai * HALF + m * 16) * 1024 + co); f32x4 xv = *px; xv = xv + gv * acc[ai][bj][m][n]; *px = xv; } }
    }
};
struct EpiRes192 {
    static constexpr bool PERM = false, AFTER_DRAIN = false;
    float* X; int nh; bf16_t* HB; float* rowss; const PG8_LAS float* tab; mutable int ord;
    __device__ __forceinline__ void operator()(const f32x4 (&acc)[2][2][3][2], const Unit& u, int wr, int wc, int fr, int fq) const {
        const int row0 = u.pm * 192 + wr * 48 + fr, col0 = u.pn * BM + wc * 32 + 8 * fq;
        const PG8_LAS float* tb = tab + ord * 1536 + wc * 32 + 8 * fq; ++ord;
        float ss[2][3];
#pragma unroll
        for (int ai = 0; ai < 2; ++ai)
#pragma unroll
            for (int m = 0; m < 3; ++m) ss[ai][m] = 0.f;
#pragma unroll
        for (int bj = 0; bj < 2; ++bj) {
            f32x4 xin[2][2][3];
#pragma unroll
            for (int n = 0; n < 2; ++n)
#pragma unroll
                for (int ai = 0; ai < 2; ++ai)
#pragma unroll
                    for (int m = 0; m < 3; ++m) xin[n][ai][m] = *(const f32x4*)(X + (size_t)(row0 + ai * 96 + m * 16) * 1024 + col0 + bj * HALF + 4 * n);
#pragma unroll
            for (int n = 0; n < 2; ++n) {
                const int co = col0 + bj * HALF + 4 * n, cl = bj * HALF + 4 * n;
                const f32x4 g0 = *(const PG8_LAS f32x4*)(tb + cl), g1 = *(const PG8_LAS f32x4*)(tb + 256 + cl), g2 = *(const PG8_LAS f32x4*)(tb + 512 + cl);
                const f32x4 w0 = *(const PG8_LAS f32x4*)(tb + 768 + cl), w1 = *(const PG8_LAS f32x4*)(tb + 1024 + cl), w2 = *(const PG8_LAS f32x4*)(tb + 1280 + cl);
#pragma unroll
                for (int ai = 0; ai < 2; ++ai)
#pragma unroll
                    for (int m = 0; m < 3; ++m) { const int row = row0 + ai * 96 + m * 16; const f32x4 gv = row < 4096 ? g0 : (row < 8192 ? g1 : g2);
                        f32x4 xv = xin[n][ai][m]; xv = xv + gv * acc[ai][bj][m][n]; *(f32x4*)(X + (size_t)row * 1024 + co) = xv;
                        if (nh) { const f32x4 wv = row < 4096 ? w0 : (row < 8192 ? w1 : w2); const f32x4 y = xv * wv;
                            ss[ai][m] += (xv[0] * xv[0] + xv[1] * xv[1]) + (xv[2] * xv[2] + xv[3] * xv[3]);
                            u32x2 o; o.x = cvt_pk_bf16(y[0], y[1]); o.y = cvt_pk_bf16(y[2], y[3]); *(u32x2*)(HB + (size_t)row * 1024 + co) = o; } } } }
        if (nh) {
#pragma unroll
            for (int ai = 0; ai < 2; ++ai)
#pragma unroll
                for (int m = 0; m < 3; ++m) { float v = ss[ai][m]; v += __shfl_xor(v, 16); v += __shfl_xor(v, 32);
                    if (fq == 0) rowss[(size_t)(row0 + ai * 96 + m * 16) * 16 + u.pn * 4 + wc] = v; } }
    }
};
struct EpiPool {
    static constexpr bool PERM = false, AFTER_DRAIN = false;
    float* X; const float* xp; const float* xs; int first; const float* gate; const float* pb; const float* ps; const float* nw; const float* sc; bf16_t* HB; float* rowss;
    __device__ __forceinline__ void operator()(const f32x4 (&acc)[2][2][4][2], const Unit& u, int wr, int wc, int fr, int fq) const {
        const int g = u.pn, tile = u.pm - g * 48;
        const int row0 = tile * BM + wr * 64 + fr, col0 = g * BM + wc * 32 + 8 * fq;
        const int cv = tile < 16 ? 0 : (tile < 32 ? 1 : 2);
        const float* xold = first ? (tile < 16 ? xp : xs - (size_t)T_CTX * 1024) : X;
#pragma unroll
        for (int ai = 0; ai < 2; ++ai)
#pragma unroll
            for (int m = 0; m < 4; ++m) { const int row = row0 + ai * HALF + m * 16; float ssv = 0.f;
                f32x4 xin[2][2];
#pragma unroll
                for (int bj = 0; bj < 2; ++bj)
#pragma unroll
                    for (int n = 0; n < 2; ++n) xin[bj][n] = *(const f32x4*)(xold + (size_t)row * 1024 + col0 + bj * HALF + 4 * n);
#pragma unroll
                for (int bj = 0; bj < 2; ++bj)
#pragma unroll
                    for (int n = 0; n < 2; ++n) { const int co = col0 + bj * HALF + 4 * n; const size_t ro = (size_t)row * 1024 + co;
                        const f32x4 gv = *(const f32x4*)(gate + cv * 6144 + co), bv = *(const f32x4*)(pb + co), sv = *(const f32x4*)(ps + co);
                        const f32x4 wv = *(const f32x4*)(nw + co) * (*(const f32x4*)(sc + cv * 6144 + co) + 1.f);
                        f32x4 xv = xin[bj][n]; xv = xv + gv * ((acc[ai][bj][m][n] + bv) * sv); *(f32x4*)(X + ro) = xv;
                        const f32x4 y = xv * wv; ssv += (xv[0] * xv[0] + xv[1] * xv[1]) + (xv[2] * xv[2] + xv[3] * xv[3]);
                        u32x2 o; o.x = cvt_pk_bf16(y[0], y[1]); o.y = cvt_pk_bf16(y[2], y[3]); *(u32x2*)(HB + ro) = o; }
                ssv += __shfl_xor(ssv, 16); ssv += __shfl_xor(ssv, 32);
                if (fq == 0) rowss[(size_t)row * 16 + g * 4 + wc] = ssv; }
    }
};
struct EpiInproj {
    static constexpr bool PERM = false, AFTER_DRAIN = false;
    bf16_t *Q, *K, *V, *Gt; const float* rope; const PG8_LAS float* tab; mutable int ord;
    __device__ __forceinline__ void operator()(const f32x4 (&acc)[2][2][4][2], const Unit& u, int wr, int wc, int fr, int fq) const {
        const int pn = u.pn, row0 = u.pm * BM + wr * 64 + fr;
        const PG8_LAS float* rt = tab + ord * 512 + wr * 64 + fr; const PG8_LAS float* bp = tab + ord * 512 + 256; ++ord;
        float rstd[2][4];
#pragma unroll
        for (int ai = 0; ai < 2; ++ai)
#pragma unroll
            for (int m = 0; m < 4; ++m) rstd[ai][m] = rt[ai * HALF + m * 16];
        if (pn < 8) {
            bf16_t* dst = (pn < 4 ? Q : K) + (pn & 3) * 256;
            const float sc = pn < 4 ? 1.f : 0.0625f;
            const bool lat = u.pm >= 16;
            const int i0 = 16 * wc + 4 * fq;
#pragma unroll
            for (int ai = 0; ai < 2; ++ai)
#pragma unroll
                for (int m = 0; m < 4; ++m) { const int row = row0 + ai * HALF + m * 16; const int t = (row - T_CTX) & 4095;
#pragma unroll
                    for (int bj = 0; bj < 2; ++bj) { const int pos = bj ? (t & 63) : (t >> 6);
                        const f32x4 bb1 = *(const PG8_LAS f32x4*)(bp + bj * HALF + i0), bb2 = *(const PG8_LAS f32x4*)(bp + bj * HALF + 64 + i0);
                        f32x4 x1 = (acc[ai][bj][m][0] * rstd[ai][m] + bb1) * sc, x2 = (acc[ai][bj][m][1] * rstd[ai][m] + bb2) * sc, o1 = x1, o2 = x2;
                        if (lat) { const f32x4 c0 = *(const f32x4*)(rope + (size_t)(pos * 64 + i0) * 2), c1 = *(const f32x4*)(rope + (size_t)(pos * 64 + i0) * 2 + 4);
                            o1[0] = x1[0] * c0[0] - x2[0] * c0[1]; o2[0] = x2[0] * c0[0] + x1[0] * c0[1];
                            o1[1] = x1[1] * c0[2] - x2[1] * c0[3]; o2[1] = x2[1] * c0[2] + x1[1] * c0[3];
                            o1[2] = x1[2] * c1[0] - x2[2] * c1[1]; o2[2] = x2[2] * c1[0] + x1[2] * c1[1];
                            o1[3] = x1[3] * c1[2] - x2[3] * c1[3]; o2[3] = x2[3] * c1[2] + x1[3] * c1[3]; }
                        bf16_t* rp = dst + (size_t)row * 1024 + bj * HALF + i0;
                        u32x2 w1, w2; w1.x = cvt_pk_bf16(o1[0], o1[1]); w1.y = cvt_pk_bf16(o1[2], o1[3]); w2.x = cvt_pk_bf16(o2[0], o2[1]); w2.y = cvt_pk_bf16(o2[2], o2[3]);
                        *(u32x2*)rp = w1; *(u32x2*)(rp + 64) = w2; } }
        } else {
            bf16_t* dst = (pn < 16 ? V + (pn - 8) * 256 : Gt + (pn - 16) * 256) + wc * 32 + 8 * fq;
#pragma unroll
            for (int ai = 0; ai < 2; ++ai)
#pragma unroll
                for (int m = 0; m < 4; ++m) { bf16_t* rowp = dst + (size_t)(row0 + ai * HALF + m * 16) * 2048;
#pragma unroll
                    for (int bj = 0; bj < 2; ++bj) { const f32x4 b0 = *(const PG8_LAS f32x4*)(bp + bj * HALF + wc * 32 + 8 * fq), b1 = *(const PG8_LAS f32x4*)(bp + bj * HALF + wc * 32 + 8 * fq + 4);
                        const f32x4 v0 = acc[ai][bj][m][0] * rstd[ai][m] + b0, v1 = acc[ai][bj][m][1] * rstd[ai][m] + b1;
                        u32x4 w; w.x = cvt_pk_bf16(v0[0], v0[1]); w.y = cvt_pk_bf16(v0[2], v0[3]); w.z = cvt_pk_bf16(v1[0], v1[1]); w.w = cvt_pk_bf16(v1[2], v1[3]);
                        *(u32x4*)(rowp + bj * HALF) = w; } }
        }
    }
};
template <class Epi, class Sched, bool ALIGN_EPI = false, bool SP2 = false, int MF = 4>
__device__ __forceinline__ void gemm_phase(PG8_LAS unsigned char* lds, const Gemm g, const Sched& S, const Epi& E, int tid_in) {
    int tid_ = tid_in; asm volatile("" : "+v"(tid_)); const int tid = tid_, wid = __builtin_amdgcn_readfirstlane(tid >> 6), lane = tid & 63, wr = wid >> 2, wc = wid & 3, fr = lane & 15, fq = lane >> 4;
    const int K = g.K, nt = K / BK;
    unsigned voffA[2], voffB[2];
#pragma unroll
    for (int i = 0; i < 2; ++i) { int R, C; stage_rc(tid * 16 + i * 8192, R, C); const int Rb = Epi::PERM ? ((R & ~31) + perm32(R & 31)) : R;
        voffA[i] = (unsigned)(R * K + C) * 2u; voffB[i] = (unsigned)(Rb * K + C) * 2u; }
    const size_t kstep = (size_t)(BK * 2);
    const size_t hstep = (size_t)HALF * K * 2, hstepA = (size_t)(32 * MF) * K * 2;
    const size_t tstep = 2 * hstep, tstepA = 2 * hstepA;
    const unsigned ldsw = (unsigned)wid * 1024u;
    const int aoff = lds_byte(wr * (16 * MF) + fr, fq * 8), boff = lds_byte(wc * 32 + fr, fq * 8);
#define PG8_SA(b, h) (((b) * 2 + (h)) * HTB)
#define PG8_SB(b, h) ((4 + (b) * 2 + (h)) * HTB)
#define PG8_STAGE(bufoff, gbase, voff) do { _Pragma("unroll") for (int _i = 0; _i < 2; ++_i) \
        __builtin_amdgcn_global_load_lds((const unsigned*)((const char*)(gbase) + (voff)[_i]), (PG8_LAS unsigned*)(lds + (bufoff) + ldsw + _i * 8192), 16, 0, 0); } while (0)
#define PG8_LDA(dst, b, h) do { _Pragma("unroll") for (int m = 0; m < MF; ++m) _Pragma("unroll") for (int k = 0; k < 2; ++k) dst[m][k] = *(const PG8_LAS bf16x8*)(lds + PG8_SA(b, h) + aoff + m * 2048 + k * 1024); } while (0)
#define PG8_LDB(dst, b, h) do { _Pragma("unroll") for (int n = 0; n < 2; ++n) _Pragma("unroll") for (int k = 0; k < 2; ++k) dst[n][k] = *(const PG8_LAS bf16x8*)(lds + PG8_SB(b, h) + boff + n * 2048 + k * 1024); } while (0)
#define PG8_MMA(ai, bj, At, Bt) do { __builtin_amdgcn_s_setprio(1); _Pragma("unroll") for (int m = 0; m < MF; ++m) _Pragma("unroll") for (int n = 0; n < 2; ++n) _Pragma("unroll") for (int k = 0; k < 2; ++k) \
        acc[ai][bj][m][n] = __builtin_amdgcn_mfma_f32_16x16x32_bf16(Bt[n][k], At[m][k], acc[ai][bj][m][n], 0, 0, 0); __builtin_amdgcn_s_setprio(0); } while (0)
#define PG8_WAIT_V(n) asm volatile("s_waitcnt vmcnt(" #n ")" ::: "memory")
#define PG8_WAIT_L(n) asm volatile("s_waitcnt lgkmcnt(" #n ")" ::: "memory")
#define PG8_BAR __builtin_amdgcn_s_barrier()
#define PG8_SCHED __builtin_amdgcn_sched_barrier(0)
    Unit cur, nxt; int ui = 0;
    if (!S.next(0, cur)) return;
    f32x4 acc[2][2][MF][2];
#pragma unroll
    for (int a = 0; a < 2; ++a)
#pragma unroll
        for (int b = 0; b < 2; ++b)
#pragma unroll
            for (int m = 0; m < MF; ++m)
#pragma unroll
                for (int n = 0; n < 2; ++n) acc[a][b][m][n] = (f32x4){0.f, 0.f, 0.f, 0.f};
    bf16x8 At[MF][2], B0[2][2], B1[2][2];
    const char* cA = (const char*)g.A + (size_t)cur.pm * tstepA; const char* cB = (const char*)g.Bt + (size_t)cur.pn * tstep;
    S.a_ready(cur);
    if constexpr (SP2) {
        PG8_STAGE(PG8_SB(0, 0), cB, voffB); PG8_STAGE(PG8_SB(0, 1), cB + hstep, voffB); PG8_STAGE(PG8_SA(0, 0), cA, voffA); PG8_STAGE(PG8_SA(0, 1), cA + hstepA, voffA);
        if (wr == 1) PG8_BAR;
        PG8_WAIT_V(2); PG8_BAR;
        PG8_STAGE(PG8_SB(1, 0), cB + kstep, voffB); PG8_STAGE(PG8_SA(1, 0), cA + kstep, voffA); PG8_STAGE(PG8_SB(1, 1), cB + hstep + kstep, voffB);
        PG8_WAIT_V(6); PG8_BAR;
    } else {
        PG8_STAGE(PG8_SB(0, 0), cB, voffB); PG8_STAGE(PG8_SA(0, 0), cA, voffA); PG8_STAGE(PG8_SB(0, 1), cB + hstep, voffB); PG8_STAGE(PG8_SA(0, 1), cA + hstepA, voffA);
        if (wr == 1) PG8_BAR;
        PG8_WAIT_V(4); PG8_BAR;
        PG8_STAGE(PG8_SB(1, 0), cB + kstep, voffB); PG8_STAGE(PG8_SA(1, 0), cA + kstep, voffA); PG8_STAGE(PG8_SB(1, 1), cB + hstep + kstep, voffB);
        PG8_WAIT_V(6); PG8_BAR;
    }
    for (;;) {
        const bool has_next = S.next(ui + 1, nxt);
        const char* nA = has_next ? (const char*)g.A + (size_t)nxt.pm * tstepA : cA; const char* nB = has_next ? (const char*)g.Bt + (size_t)nxt.pn * tstep : cB;
        for (int t = 0; t < nt; t += 2) {
            const bool last = (t == nt - 2);
            const char* a1 = cA + (size_t)(t + 1) * kstep;
            const char* a2 = last ? nA : cA + (size_t)(t + 2) * kstep; const char* b2 = last ? nB : cB + (size_t)(t + 2) * kstep;
            const char* a3 = a2 + kstep; const char* b3 = b2 + kstep;
            if (last && has_next) S.a_ready(nxt);
            if constexpr (SP2) {
            PG8_LDB(B0, 0, 0); PG8_LDB(B1, 0, 1); PG8_SCHED; PG8_LDA(At, 0, 0); PG8_STAGE(PG8_SA(1, 1), a1 + hstepA, voffA);
            PG8_WAIT_V(8); PG8_WAIT_L(0); PG8_BAR; PG8_MMA(0, 0, At, B0); PG8_MMA(0, 1, At, B1); PG8_BAR; PG8_SCHED;
            PG8_LDA(At, 0, 1); PG8_STAGE(PG8_SB(0, 0), b2, voffB); PG8_STAGE(PG8_SB(0, 1), b2 + hstep, voffB); PG8_STAGE(PG8_SA(0, 0), a2, voffA);
            PG8_WAIT_V(8); PG8_WAIT_L(0); PG8_BAR; PG8_MMA(1, 0, At, B0); PG8_MMA(1, 1, At, B1); PG8_BAR; PG8_SCHED;
            PG8_LDB(B0, 1, 0); PG8_LDB(B1, 1, 1); PG8_SCHED; PG8_LDA(At, 1, 0); PG8_STAGE(PG8_SA(0, 1), a2 + hstepA, voffA);
            PG8_WAIT_V(8); PG8_WAIT_L(0); PG8_BAR; PG8_MMA(0, 0, At, B0); PG8_MMA(0, 1, At, B1); PG8_BAR; PG8_SCHED;
            PG8_LDA(At, 1, 1); PG8_STAGE(PG8_SB(1, 0), b3, voffB); PG8_STAGE(PG8_SB(1, 1), b3 + hstep, voffB); PG8_STAGE(PG8_SA(1, 0), a3, voffA);
            PG8_WAIT_V(8); PG8_WAIT_L(0); PG8_BAR; PG8_MMA(1, 0, At, B0); PG8_MMA(1, 1, At, B1); PG8_BAR; PG8_SCHED;
            } else {
            PG8_LDB(B0, 0, 0); PG8_SCHED; PG8_LDA(At, 0, 0); PG8_STAGE(PG8_SA(1, 1), a1 + hstepA, voffA);
            PG8_WAIT_L(8); PG8_BAR; PG8_WAIT_L(0); PG8_MMA(0, 0, At, B0); PG8_BAR; PG8_SCHED;
            PG8_LDB(B1, 0, 1); PG8_STAGE(PG8_SB(0, 0), b2, voffB);
            PG8_BAR; PG8_WAIT_L(0); PG8_MMA(0, 1, At, B1); PG8_BAR;
            PG8_LDA(At, 0, 1); PG8_STAGE(PG8_SA(0, 0), a2, voffA);
            PG8_BAR; PG8_WAIT_L(0); PG8_MMA(1, 0, At, B0); PG8_BAR; PG8_SCHED;
            PG8_STAGE(PG8_SB(0, 1), b2 + hstep, voffB);
            PG8_WAIT_V(6); PG8_BAR; PG8_MMA(1, 1, At, B1); PG8_BAR;
            PG8_LDB(B0, 1, 0); PG8_SCHED; PG8_LDA(At, 1, 0); PG8_STAGE(PG8_SA(0, 1), a2 + hstepA, voffA);
            PG8_WAIT_L(8); PG8_BAR; PG8_WAIT_L(0); PG8_MMA(0, 0, At, B0); PG8_BAR; PG8_SCHED;
            PG8_LDB(B1, 1, 1); PG8_STAGE(PG8_SB(1, 0), b3, voffB);
            PG8_BAR; PG8_WAIT_L(0); PG8_MMA(0, 1, At, B1); PG8_BAR;
            PG8_LDA(At, 1, 1); PG8_STAGE(PG8_SA(1, 0), a3, voffA);
            PG8_BAR; PG8_WAIT_L(0); PG8_MMA(1, 0, At, B0); PG8_BAR; PG8_SCHED;
            PG8_STAGE(PG8_SB(1, 1), b3 + hstep, voffB);
            PG8_WAIT_V(6); PG8_BAR; PG8_MMA(1, 1, At, B1); PG8_BAR;
            }
        }
        if constexpr (ALIGN_EPI) { if (wr == 0) PG8_BAR; }
        if constexpr (!Epi::AFTER_DRAIN) { E(acc, cur, wr, wc, fr, fq); S.done(cur); }
        if (!has_next) break;
#pragma unroll
        for (int a = 0; a < 2; ++a)
#pragma unroll
            for (int b = 0; b < 2; ++b)
#pragma unroll
                for (int m = 0; m < MF; ++m)
#pragma unroll
                    for (int n = 0; n < 2; ++n) acc[a][b][m][n] = (f32x4){0.f, 0.f, 0.f, 0.f};
        cur = nxt; cA = nA; cB = nB; ++ui;
        if constexpr (ALIGN_EPI) { if (wr == 1) PG8_BAR; }
    }
    PG8_WAIT_V(0);
    if constexpr (!ALIGN_EPI) { if (wr == 0) PG8_BAR; }
    PG8_BAR;
    if constexpr (Epi::AFTER_DRAIN) { E.fused(acc, cur, wr, wc, fr, fq, lds, wid, lane); S.done(cur); }
#undef PG8_SA
#undef PG8_SB
#undef PG8_STAGE
#undef PG8_LDA
#undef PG8_LDB
#undef PG8_MMA
#undef PG8_WAIT_V
#undef PG8_WAIT_L
#undef PG8_BAR
#undef PG8_SCHED
}
}
#define XB_TMO      128
#define XB_XCNT(j)  (256  + 64 * (j))
#define XB_XSUB(j)  (1280 + 64 * (j))
#define XB_XGEN(j)  (2304 + 64 * (j))
#define XB_TOP      3328
#define XB_TOPGEN   3392
#define XCD_BAR_WORDS 3456
#define XB_SPIN_CAP (1u << 18)

__device__ __forceinline__ unsigned xb_ld(unsigned* p)              { return __hip_atomic_load(p, __ATOMIC_RELAXED, __HIP_MEMORY_SCOPE_AGENT); }
__device__ __forceinline__ unsigned xb_add(unsigned* p, unsigned v) { return __hip_atomic_fetch_add(p, v, __ATOMIC_RELAXED, __HIP_MEMORY_SCOPE_AGENT); }
__device__ __forceinline__ unsigned xb_xcc_id() { return (unsigned)__builtin_amdgcn_s_getreg((3 << 11) | 20) & 0xFu; }
#define XB_SPIN(cond, bar) do { unsigned _sp = 0; while (cond) { __builtin_amdgcn_s_sleep(1); \
    if ((++_sp & 255u) == 0u) { if (xb_ld(&(bar)[XB_TMO])) break; if (_sp > XB_SPIN_CAP) { atomicAdd(&(bar)[XB_TMO], 1u); break; } } } } while (0)

struct XcdBarrier {
    int w0;
    unsigned* bar; unsigned x;
    volatile LAS unsigned* st;
};

__device__ __forceinline__ XcdBarrier xcd_barrier_post(unsigned* bar, volatile LAS unsigned* st) {
    XcdBarrier b; b.bar = bar; b.x = xb_xcc_id(); b.st = st;
    if (threadIdx.x == 0) (void)xb_add(&bar[XB_XCNT(b.x)], 1u);
    return b;
}
__device__ __forceinline__ void xcd_barrier_complete(unsigned* bar, unsigned x, unsigned& nloc, unsigned& nx) {
    const unsigned G = gridDim.x * gridDim.y * gridDim.z;
    unsigned sum, cnt, mine, sp = 0u;
    for (;;) {
        sum = 0u; cnt = 0u; mine = 0u;
#pragma unroll
        for (unsigned j = 0; j < 16; ++j) { const unsigned c = xb_ld(&bar[XB_XCNT(j)]); sum += c; cnt += (c > 0u) ? 1u : 0u; mine = (j == x) ? c : mine; }
        if (sum == G) break;
        __builtin_amdgcn_s_sleep(1);
        if ((++sp & 255u) == 0u) { if (xb_ld(&bar[XB_TMO])) break; if (sp > XB_SPIN_CAP) { atomicAdd(&bar[XB_TMO], 1u); break; } }
    }
    nloc = mine > 0u ? mine : 1u; nx = cnt > 0u ? cnt : 1u;
}

__device__ __forceinline__ void xcd_barrier(const XcdBarrier& b) {
    asm volatile("s_waitcnt vmcnt(0)" ::: "memory");
    __syncthreads();
    if (tid_from_wave(b.w0) == 0) {
        unsigned* bar = b.bar;
        __builtin_amdgcn_s_waitcnt(0);
        unsigned nloc = b.st[0], nx = b.st[1];
        if (nloc == 0u) { xcd_barrier_complete(bar, b.x, nloc, nx); b.st[0] = nloc; b.st[1] = nx; }
        const unsigned old = xb_add(&bar[XB_XSUB(b.x)], 1u);
        const unsigned gen = old / nloc;
        if (old + 1u == (gen + 1u) * nloc) {
            __builtin_amdgcn_fence(__ATOMIC_RELEASE, "agent");
            asm volatile("s_waitcnt vmcnt(0)" ::: "memory");
            const unsigned og = xb_add(&bar[XB_TOP], 1u);
            const unsigned tg = og / nx;
            if (og + 1u == (tg + 1u) * nx) xb_add(&bar[XB_TOPGEN], 1u);
            else XB_SPIN(xb_ld(&bar[XB_TOPGEN]) == tg, bar);
            __builtin_amdgcn_fence(__ATOMIC_ACQUIRE, "agent");
            xb_add(&bar[XB_XGEN(b.x)], 1u);
            asm volatile("s_waitcnt vmcnt(0)" ::: "memory");
        } else {
            XB_SPIN(xb_ld(&bar[XB_XGEN(b.x)]) == gen, bar);
            __builtin_amdgcn_fence(__ATOMIC_ACQUIRE, "agent");
            asm volatile("s_waitcnt vmcnt(0)" ::: "memory");
        }
    }
    __syncthreads();
}

struct Ctx { const Params* p; unsigned char* ws; float* out; LAS unsigned char* lds; int tid, lane, wave, gw, ngw, bid, G; };
__device__ __forceinline__ Ctx fresh_ctx(const Params* pp, LAS unsigned char* lds, int wave0);
__device__ __forceinline__ Ctx fresh_ctx(const Params* pp, LAS unsigned char* lds, int wave0) {
    Ctx c; c.p = pp; c.lds = lds;
    int tid = tid_from_wave(wave0); asm volatile("" : "+v"(tid));
    int bid = blockIdx.x; asm volatile("" : "+s"(bid));
    int G = gridDim.x; asm volatile("" : "+s"(G));
    unsigned char* ws = pp->ws; asm volatile("" : "+s"(ws));
    float* out = pp->out; asm volatile("" : "+s"(out));
    c.tid = tid; c.lane = tid & 63; c.wave = __builtin_amdgcn_readfirstlane(tid >> 6); c.bid = bid; c.G = G; c.ws = ws; c.out = out; c.gw = bid * NWAVES + c.wave; c.ngw = G * NWAVES;
    return c;
}
__device__ __forceinline__ const float* inp(const Ctx& c, int i) { asm volatile("" : "+s"(i)); return c.p->in[i]; }

__device__ __forceinline__ void p0_transpose_item(const float* W, int K, int N, bf16_t* WT, LAS float* scr, int item, int lane, int mode, const float* sh = nullptr, float* biasp = nullptr) {
    const int nblk = N / 32, kb = item / nblk, nb = item % nblk, k0 = 64 * kb, n0 = 32 * nb;
#pragma unroll 8
    for (int i = 0; i < 32; ++i) { const int kk = 2 * i + (lane >> 5); scr[kk * 33 + (lane & 31)] = __builtin_nontemporal_load(W + (size_t)(k0 + kk) * N + n0 + (lane & 31)); }
    if (sh) { LAS float* shl = scr + 64 * 33;
#pragma unroll
        for (int cvv = 0; cvv < 3; ++cvv) shl[cvv * 64 + lane] = sh[(size_t)cvv * NMOD + k0 + lane]; }
    asm volatile("s_waitcnt lgkmcnt(0)" ::: "memory");
    if (sh) { const LAS float* shl = scr + 64 * 33; const int n = lane & 31, kh = (lane >> 5) * 32; float a0 = 0.f, a1 = 0.f, a2 = 0.f;
#pragma unroll 8
        for (int kk = 0; kk < 32; ++kk) { const float wv = scr[(kh + kk) * 33 + n]; a0 += shl[kh + kk] * wv; a1 += shl[64 + kh + kk] * wv; a2 += shl[128 + kh + kk] * wv; }
        a0 += __shfl_xor(a0, 32); a1 += __shfl_xor(a1, 32); a2 += __shfl_xor(a2, 32);
        if (lane < 32) { float* o = biasp + (size_t)(kb * 3) * N + n0 + n; o[0] = a0; o[N] = a1; o[2 * (size_t)N] = a2; } }
    const int c = lane & 7;
#pragma unroll
    for (int j = 0; j < 4; ++j) { const int n = (lane >> 3) + 8 * j; const LAS float* s = scr + (8 * c) * 33 + n;
        u32x4 o; o.x = cvt_pk_bf16(s[0 * 33], s[1 * 33]); o.y = cvt_pk_bf16(s[2 * 33], s[3 * 33]); o.z = cvt_pk_bf16(s[4 * 33], s[5 * 33]); o.w = cvt_pk_bf16(s[6 * 33], s[7 * 33]);
        const int L = n0 + n, Pn = (mode == 1 && L < 2048) ? permrope(L) : perm8(L);
        *(u32x4*)(WT + (size_t)Pn * K + k0 + 8 * c) = o; }
    asm volatile("s_waitcnt lgkmcnt(0)" ::: "memory");
}
__device__ __forceinline__ void phase_p0(const Ctx& c) {
    unsigned char* ws = c.ws;
    { LAS float* sl = (LAS float*)c.lds;
      float* modp = (float*)(ws + WS_MODP);
      for (int u = c.bid; u < 768; u += c.G) {
        const int l = u / 192, rem = u % 192, kc = rem / 12, nb = rem % 12, n = nb * 512 + c.tid;
        __syncthreads();
        if (c.tid < 192) { const int cvv = c.tid >> 6, k = 64 * kc + (c.tid & 63); const float v = cvv == 0 ? inp(c, I_CCTX)[k] : inp(c, I_C)[(cvv - 1) * 1024 + k]; sl[c.tid] = silu_f(v); }
        __syncthreads();
        float a0 = 0.f, a1 = 0.f, a2 = 0.f; const float* w = inp(c, I_WADA) + ((size_t)l * 1024 + 64 * kc) * NMOD + n;
#pragma unroll 8
        for (int k = 0; k < 64; ++k) { const float wv = __builtin_nontemporal_load(w + (size_t)k * NMOD); a0 += sl[k] * wv; a1 += sl[64 + k] * wv; a2 += sl[128 + k] * wv; }
        float* o = modp + (size_t)((l * 16 + kc) * 3) * NMOD + n; o[0] = a0; o[NMOD] = a1; o[2 * NMOD] = a2;
      }
      __syncthreads();
    }
    { float* rope = (float*)(ws + WS_TAB + TAB_ROPE); float* pw = (float*)(ws + WS_TAB + TAB_POW);
      const int gt = c.bid * NTHREADS + c.tid, ngt = c.G * NTHREADS;
      for (int i = gt; i < 4096; i += ngt) { const int pos = i >> 6, fi = i & 63; const float fr = powf(10000.f, -(float)fi / 64.f); const float ang = (float)pos * fr; rope[2 * i] = cosf(ang); rope[2 * i + 1] = sinf(ang); }
      for (int i = gt; i < 16 * 132; i += ngt) { const int n = i % 132, q = i / 132; const float lg = log1pf(-exp2f(-inp(c, I_DECAY)[q])); pw[i] = expf(lg * (float)n); }
    }
    { LAS float* scr = (LAS float*)(c.lds + c.wave * 9216);
      constexpr int I2 = 2048, IOUT = 1024, IP = 32;
      constexpr int NIT = 4 * I2 + 2 * IOUT + 8 * IP;
      for (int it = c.gw; it < NIT; it += c.ngw) {
        int r = it;
        if (r < 4 * I2) { const int l = r / I2; p0_transpose_item(inp(c, I_W2) + (size_t)l * 4096 * 1024, 4096, 1024, (bf16_t*)(ws + WS_W2T) + (size_t)l * 1024 * 4096, scr, r % I2, c.lane, 0); continue; } r -= 4 * I2;
        if (r < 2 * IOUT) { const int l = r / IOUT; p0_transpose_item(inp(c, I_WOUT) + (size_t)l * HV * 1024, HV, 1024, (bf16_t*)(ws + WS_WOUTT) + (size_t)l * 1024 * HV, scr, r % IOUT, c.lane, 0); continue; } r -= 2 * IOUT;
        { const int l = r / IP; p0_transpose_item(inp(c, I_PW) + (size_t)l * 65536, 256, 256, (bf16_t*)(ws + WS_PWT) + (size_t)l * 65536, scr, r % IP, c.lane, 0); }
      }
    }
}
__device__ __forceinline__ void phase_p0c(const Ctx& c) {
    unsigned char* ws = c.ws; const float* mod = (const float*)(ws + WS_MOD); float* biasp = (float*)(ws + WS_BIASP);
    LAS float* scr = (LAS float*)(c.lds + c.wave * 9216);
    constexpr int I1 = 2048, IIN = 3072, NIT = 4 * I1 + 2 * IIN;
    for (int it = c.gw; it < NIT; it += c.ngw) {
        int r = it;
        if (r < 4 * I1) { const int l = r / I1; p0_transpose_item(inp(c, I_W1) + (size_t)l * 1024 * 4096, 1024, 4096, (bf16_t*)(ws + WS_W1T) + (size_t)l * 4096 * 1024, scr, r % I1, c.lane, 0,
                                                                   mod + (size_t)(l * 3) * NMOD + 3 * 1024, biasp + (size_t)l * 16 * 3 * 4096); continue; } r -= 4 * I1;
        { const int jr = r / IIN, l = 2 * jr + 1; p0_transpose_item(inp(c, I_WIN) + (size_t)jr * 1024 * RIN, 1024, RIN, (bf16_t*)(ws + WS_WINT) + (size_t)jr * RIN * 1024, scr, r % IIN, c.lane, 1,
                                                                   mod + (size_t)(l * 3) * NMOD, biasp + (size_t)4 * 16 * 3 * 4096 + (size_t)jr * 16 * 3 * RIN); }
    }
}
__device__ __forceinline__ void bias_finalize(const Ctx& c) {
    const float* biasp = (const float*)(c.ws + WS_BIASP); float* bu = (float*)(c.ws + WS_BIASU); float* bi = (float*)(c.ws + WS_BIASI);
    const int gt = c.bid * NTHREADS + c.tid, ngt = c.G * NTHREADS;
    for (int i = gt; i < 4 * 3 * 4096 + 2 * 3 * RIN; i += ngt) {
        const bool up = i < 4 * 3 * 4096; const int q = up ? i : i - 4 * 3 * 4096, N = up ? 4096 : RIN, n = q % N, cvv = (q / N) % 3, l = q / (3 * N);
        const float* src = biasp + (up ? (size_t)l * 16 * 3 * 4096 : (size_t)4 * 16 * 3 * 4096 + (size_t)l * 16 * 3 * RIN) + (size_t)cvv * N + n;
        float s = 0.f;
#pragma unroll
        for (int kb = 0; kb < 16; ++kb) s += src[(size_t)kb * 3 * N];
        (up ? bu : bi)[q] = s; }
}
__device__ __forceinline__ void phase_p0b(const Ctx& c) {
    const float* modp = (const float*)(c.ws + WS_MODP); float* mod = (float*)(c.ws + WS_MOD);
    const int gt = c.bid * NTHREADS + c.tid, ngt = c.G * NTHREADS;
    for (int i = gt; i < 4 * 3 * NMOD; i += ngt) { const int n = i % NMOD, cvv = (i / NMOD) % 3, l = i / (3 * NMOD);
        float s = inp(c, I_BADA)[l * NMOD + n];
#pragma unroll
        for (int kc = 0; kc < 16; ++kc) s += modp[(size_t)((l * 16 + kc) * 3 + cvv) * NMOD + n];
        mod[i] = s; }
}
template <int MODE> __device__ __forceinline__ void phase_norm(const Ctx& c, int l, int which, int from_input) {
    const float* X = (const float*)(c.ws + WS_X); const float* mod = (const float*)(c.ws + WS_MOD);
    const float* nw = MODE == 2 ? inp(c, I_FNW) : (which ? inp(c, I_NMLP) : inp(c, I_NMIX)) + l * 1024;
    for (int row = c.gw; row < T; row += c.ngw) {
        const float* xr = from_input ? (row < T_CTX ? inp(c, I_XP) + (size_t)row * 1024 : inp(c, I_XS) + (size_t)(row - T_CTX) * 1024) : X + (size_t)row * 1024;
        f32x4 v[4]; float ss = 0.f;
#pragma unroll
        for (int j = 0; j < 4; ++j) { v[j] = *(const f32x4*)(xr + 4 * c.lane + 256 * j); ss += (v[j][0] * v[j][0] + v[j][1] * v[j][1]) + (v[j][2] * v[j][2] + v[j][3] * v[j][3]); }
        const float rstd = rsqrtf(wave_sum(ss) * (1.f / 1024.f) + NORM_EPS);
        const float* mrow = mod + (size_t)(l * 3 + cv_of_row(row)) * NMOD + (which ? 3 : 0) * 1024;
#pragma unroll
        for (int j = 0; j < 4; ++j) { const int col = 4 * c.lane + 256 * j; const f32x4 w = *(const f32x4*)(nw + col); f32x4 h = v[j] * rstd * w;
            if (MODE != 2) { const f32x4 sh = *(const f32x4*)(mrow + col), sc = *(const f32x4*)(mrow + 1024 + col); h = h * (sc + 1.f) + sh; }
            if (MODE == 0) { u32x2 o; o.x = cvt_pk_bf16(h[0], h[1]); o.y = cvt_pk_bf16(h[2], h[3]); *(u32x2*)((bf16_t*)(c.ws + WS_HB) + (size_t)row * 1024 + col) = o; }
            else if (MODE == 1) { u32x2 o; o.x = cvt_pk_bf16(h[0], h[1]); o.y = cvt_pk_bf16(h[2], h[3]); *(u32x2*)((bf16_t*)(c.ws + WS_HF32) + (size_t)row * 1024 + col) = o; }
            else __builtin_nontemporal_store(h, (f32x4*)(c.out + (size_t)row * 1024 + col)); }
    }
}
__device__ __forceinline__ void up8(const u32x4 v, f32x4& a, f32x4& b) {
    a = (f32x4){bf2f(v.x & 0xffffu), bf2f(v.x >> 16), bf2f(v.y & 0xffffu), bf2f(v.y >> 16)}; b = (f32x4){bf2f(v.z & 0xffffu), bf2f(v.z >> 16), bf2f(v.w & 0xffffu), bf2f(v.w >> 16)}; }
__device__ __forceinline__ u32x4 pk8(const f32x4 a, const f32x4 b) { u32x4 o; o.x = cvt_pk_bf16(a[0], a[1]); o.y = cvt_pk_bf16(a[2], a[3]); o.z = cvt_pk_bf16(b[0], b[1]); o.w = cvt_pk_bf16(b[2], b[3]); return o; }
__device__ __forceinline__ void slide16b(const bf16_t* src, int base, int stride, int L, int w, int p0, const bf16_t* hsub, u32x4 (&outp)[16]) {
    const int h2 = w >> 1;
    const int lo0 = max(p0 - h2, 0), hi0 = min(p0 - h2 + w, L);
    f32x4 Sa = {0.f, 0.f, 0.f, 0.f}, Sb = {0.f, 0.f, 0.f, 0.f};
#pragma unroll
    for (int k = 0; k < 16; ++k) { const int q = lo0 + k; f32x4 a, b; up8(*(const u32x4*)(src + (size_t)(base + min(q, L - 1) * stride) * 1024), a, b); if (q < hi0) { Sa = Sa + a; Sb = Sb + b; } }
#pragma unroll
    for (int k = 0; k < 16; ++k) { const int p = p0 + k;
        if (k > 0) { const int qa = p - 1 - h2, qb = p - h2 + w - 1; f32x4 a0, b0, a1, b1;
            up8(*(const u32x4*)(src + (size_t)(base + max(qa, 0) * stride) * 1024), a0, b0); up8(*(const u32x4*)(src + (size_t)(base + min(qb, L - 1) * stride) * 1024), a1, b1);
            if (qa >= 0) { Sa = Sa - a0; Sb = Sb - b0; }
            if (qb < L) { Sa = Sa + a1; Sb = Sb + b1; } }
        const int lo = max(p - h2, 0), hi = min(p - h2 + w, L); const float inv = 1.f / (float)(hi - lo);
        f32x4 ma = Sa * inv, mb = Sb * inv;
        if (hsub) { f32x4 ha, hb; up8(*(const u32x4*)(hsub + (size_t)(base + p * stride) * 1024), ha, hb); ma = ma - ha; mb = mb - hb; }
        outp[k] = pk8(ma, mb); }
}
__device__ __forceinline__ void phase_pool_v(const Ctx& c) {
    const bf16_t* hf = (const bf16_t*)(c.ws + WS_HF32); bf16_t* vs = (bf16_t*)(c.ws + WS_VS);
    const int gt = c.bid * NTHREADS + c.tid, ngt = c.G * NTHREADS;
    for (int i = gt; i < 768 * 128; i += ngt) { const int seg = i >> 7, ch = (i & 127) * 8, w = 2 << (ch >> 8);
        int base, stride, L, p0;
        if (seg < 256) { base = (seg >> 4) * 256; stride = 1; L = 256; p0 = (seg & 15) * 16; }
        else { const int s2 = seg - 256, cc = s2 & 63, rs = (s2 >> 6) & 3, b = s2 >> 8; base = T_CTX + b * 4096 + cc; stride = 64; L = 64; p0 = rs * 16; }
        u32x4 o[16];
        slide16b(hf + ch, base, stride, L, w, p0, nullptr, o);
#pragma unroll
        for (int k = 0; k < 16; ++k) *(u32x4*)(vs + (size_t)(base + (p0 + k) * stride) * 1024 + ch) = o[k]; }
}
__device__ __forceinline__ void phase_pool_h(const Ctx& c) {
    const bf16_t* hf = (const bf16_t*)(c.ws + WS_HF32); const bf16_t* vs = (const bf16_t*)(c.ws + WS_VS); bf16_t* db = (bf16_t*)(c.ws + WS_DBUF);
    const int gt = c.bid * NTHREADS + c.tid, ngt = c.G * NTHREADS;
    for (int i = gt; i < 768 * 128; i += ngt) { const int seg = i >> 7, ch = (i & 127) * 8, g = ch >> 8, w = 2 << g;
        const int t0 = seg * 16;
        u32x4 o[16];
        if (seg < 256) {
            u32x4 mv[16], hv[16];
#pragma unroll
            for (int k = 0; k < 16; ++k) { mv[k] = *(const u32x4*)(vs + (size_t)(t0 + k) * 1024 + ch); hv[k] = *(const u32x4*)(hf + (size_t)(t0 + k) * 1024 + ch); }
#pragma unroll
            for (int k = 0; k < 16; ++k) { f32x4 ma, mb, ha, hb; up8(mv[k], ma, mb); up8(hv[k], ha, hb); o[k] = pk8(ma - ha, mb - hb); }
        } else slide16b(vs + ch, t0 & ~63, 1, 64, w, t0 & 63, hf + ch, o);
#pragma unroll
        for (int k = 0; k < 16; ++k) *(u32x4*)(db + ((size_t)g * T + t0 + k) * 256 + (ch & 255)) = o[k]; }
}
__device__ __forceinline__ void phase_tr(const Ctx& c) {
    LAS unsigned char* scr = c.lds + c.wave * 8448;
    const int lane = c.lane;
#define TR_LOAD(dst8, item) do { const int tb_ = (item) % 192, cb_ = (item) / 192; const bf16_t* src_ = cb_ < 16 ? (const bf16_t*)(c.ws + WS_K) + cb_ * 64 : (const bf16_t*)(c.ws + WS_V) + (cb_ - 16) * 64; const int ld_ = cb_ < 16 ? 1024 : 2048; \
    _Pragma("unroll") for (int i = 0; i < 8; ++i) { const int pc = lane + 64 * i; dst8[i] = *(const u32x4*)(src_ + (size_t)(tb_ * 64 + (pc >> 3)) * ld_ + (pc & 7) * 8); } } while (0)
    u32x4 cur[8], nxt[8];
    if (c.gw < 192 * 48) TR_LOAD(cur, c.gw);
    for (int it = c.gw; it < 192 * 48; it += c.ngw) {
        const int tb = it % 192, cb = it / 192;
        bf16_t* dst = cb < 16 ? (bf16_t*)(c.ws + WS_KT) + (size_t)(cb * 64) * T : (bf16_t*)(c.ws + WS_VT) + (size_t)((cb - 16) * 64) * T;
        const int tok0 = tb * 64;
        const bool more = it + c.ngw < 192 * 48;
        if (more) TR_LOAD(nxt, it + c.ngw);
#pragma unroll
        for (int i = 0; i < 8; ++i) { const int pc = lane + 64 * i, r = pc >> 3, ch = pc & 7; const u32x4 v = cur[i];
            LAS unsigned* d = (LAS unsigned*)(scr + r * 132 + ch * 16); d[0] = v.x; d[1] = v.y; d[2] = v.z; d[3] = v.w; }
        asm volatile("s_waitcnt lgkmcnt(0)" ::: "memory");
        const int tg = lane & 7, cl = lane >> 3;
#pragma unroll
        for (int i = 0; i < 8; ++i) { const int col = cl + 8 * i; const LAS bf16_t* s = (const LAS bf16_t*)(scr + (tg * 8) * 132 + col * 2);
            u32x4 o; o.x = (unsigned)s[0] | ((unsigned)s[66] << 16); o.y = (unsigned)s[2 * 66] | ((unsigned)s[3 * 66] << 16); o.z = (unsigned)s[4 * 66] | ((unsigned)s[5 * 66] << 16); o.w = (unsigned)s[6 * 66] | ((unsigned)s[7 * 66] << 16);
            if (cb < 16) { const int dd = (cb & 3) * 64 + col, j0 = (tok0 & 127) + 8 * tg;
                const int frag = (((((tok0 >> 7) * 4 + (cb >> 2)) * 8 + (dd >> 5)) * 2 + ((dd >> 2) & 1)) * 4 + (j0 >> 5)) * 64 + ((j0 >> 3) & 3) * 16 + ((((dd >> 3) & 3) << 2) | (dd & 3));
                *(u32x4*)((bf16_t*)(c.ws + WS_KT) + (size_t)frag * 8) = o; }
            else *(u32x4*)(dst + (size_t)col * T + tok0 + tg * 8) = o; }
        asm volatile("s_waitcnt lgkmcnt(0)" ::: "memory");
        if (more) {
#pragma unroll
            for (int i = 0; i < 8; ++i) cur[i] = nxt[i]; }
    }
#undef TR_LOAD
}
#define MFMA16(a, b, c) __builtin_amdgcn_mfma_f32_16x16x32_bf16((a), (b), (c), 0, 0, 0)
__device__ __forceinline__ size_t sbuf_index(int slot, int h, int dir) {
    return slot >= 32 ? (size_t)(((slot - 32) * 4 + h) * 2 + dir) : (size_t)(512 + (((slot >> 1) * 4 + h) * 2 + dir));
}
#define R1_LOADA(dst, chunk_tok0) do { _Pragma("unroll") for (int md_ = 0; md_ < 2; ++md_) _Pragma("unroll") for (int ks_ = 0; ks_ < 4; ++ks_) \
    dst[md_][ks_] = *(const bf16x8*)(KTg + ((size_t)((((((chunk_tok0) >> 7) * 4 + h) * 8 + w) * 2 + md_) * 4 + ks_) * 64 + lane) * 8); } while (0)
#define R1_LOADV(dst, chunk_tok0) do { _Pragma("unroll") for (int i_ = 0; i_ < 2; ++i_) { const int pc_ = tid + 512 * i_; \
    dst[i_] = *(const u32x4*)(VTg + (size_t)(h * 512 + 64 * es + (pc_ >> 4)) * T + (chunk_tok0) + (pc_ & 15) * 8); } } while (0)
#define R1_WRITEV(src, buf) do { _Pragma("unroll") for (int i_ = 0; i_ < 2; ++i_) { const int pc_ = tid + 512 * i_, r_ = pc_ >> 4, cj_ = pc_ & 15; const u32x4 v_ = src[i_]; \
    const LAS float* z_ = zl + (dir ? cj_ * 8 : 127 - cj_ * 8); const int zs_ = dir ? 1 : -1; u32x4 o_; \
    o_.x = cvt_pk_bf16(bf2f(v_.x & 0xffffu) * z_[0], bf2f(v_.x >> 16) * z_[zs_]); o_.y = cvt_pk_bf16(bf2f(v_.y & 0xffffu) * z_[2 * zs_], bf2f(v_.y >> 16) * z_[3 * zs_]); \
    o_.z = cvt_pk_bf16(bf2f(v_.z & 0xffffu) * z_[4 * zs_], bf2f(v_.z >> 16) * z_[5 * zs_]); o_.w = cvt_pk_bf16(bf2f(v_.w & 0xffffu) * z_[6 * zs_], bf2f(v_.w >> 16) * z_[7 * zs_]); \
    *(LAS u32x4*)(vT + (buf) * 17408 + r_ * 272 + cj_ * 16) = o_; } } while (0)
#ifndef R1_STORE_REP
#define R1_STORE_REP 1
#endif
#define R1_STEP(ci_, Acur) do { const int ci = (ci_); const int ch = dir ? nch - 1 - ci : ci, slot = slot_base + ch; \
    __syncthreads(); \
    if (lat || ci == 1) { bf16_t* so = sb + sbuf_index(slot, h, dir) * 131072; \
        _Pragma("unroll") for (int ne = 0; ne < 4; ++ne) { u32x4 o; o.x = cvt_pk_bf16(acc[0][ne][0], acc[0][ne][1]); o.y = cvt_pk_bf16(acc[0][ne][2], acc[0][ne][3]); o.z = cvt_pk_bf16(acc[1][ne][0], acc[1][ne][1]); o.w = cvt_pk_bf16(acc[1][ne][2], acc[1][ne][3]); \
            __builtin_nontemporal_store(o, (u32x4*)(so + ((size_t)((es * 8 + w) * 4 + ne) * 64 + lane) * 8)); } } \
    if (ci + 1 < nch) R1_WRITEV(vraw, (ci + 1) & 1); \
    if (ci + 2 < nch) { const int ch2 = dir ? nch - 3 - ci : ci + 2; R1_LOADV(vraw, tok_base + ch2 * 128); } \
    _Pragma("unroll") for (int md = 0; md < 2; ++md) _Pragma("unroll") for (int ne = 0; ne < 4; ++ne) acc[md][ne] = acc[md][ne] * gC; \
    _Pragma("unroll") for (int ks = 0; ks < 4; ++ks) { bf16x8 b[4]; \
        _Pragma("unroll") for (int ne = 0; ne < 4; ++ne) b[ne] = *(const LAS bf16x8*)(vT + (ci & 1) * 17408 + (16 * ne + fr) * 272 + ks * 64 + fq * 16); \
        _Pragma("unroll") for (int md = 0; md < 2; ++md) _Pragma("unroll") for (int ne = 0; ne < 4; ++ne) acc[md][ne] = MFMA16(Acur[md][ks], b[ne], acc[md][ne]); } \
    if (ci + 2 < nch) { const int ch2 = dir ? nch - 3 - ci : ci + 2; R1_LOADA(Acur, tok_base + ch2 * 128); } } while (0)
__device__ __forceinline__ void phase_r1(const Ctx& c, int jr) {
    LAS unsigned char* vT = c.lds;
    LAS float* zl = (LAS float*)(c.lds + 2 * 17408);
    const bf16_t* KTg = (const bf16_t*)(c.ws + WS_KT); const bf16_t* VTg = (const bf16_t*)(c.ws + WS_VT);
    bf16_t* sb = (bf16_t*)(c.ws + WS_SBUF); const float* pwt = (const float*)(c.ws + WS_TAB + TAB_POW);
    const int tid = c.tid, w = c.wave, lane = c.lane, fr = lane & 15, fq = lane >> 4;
    const int nb = c.G, half = nb / 2; const bool lat = c.bid < half;
    const int ntask = lat ? 128 : 1024;
#ifndef R1_CTX_BLOCKS
#define R1_CTX_BLOCKS (nb - half)
#endif
    int bb = lat ? c.bid : c.bid - half; const int nbl = lat ? half : R1_CTX_BLOCKS;
    for (int tq = (lat || bb < nbl) ? bb : ntask; tq < ntask; tq += nbl) {
        int tk = tq;
        if (nbl == 128) { const int x = bb & 7, r = bb >> 3; tk = lat ? ((x * 2 + (r >> 3)) * 8 + (r & 7)) : (((r * 8 + x) * 8) + (tq >> 7)); }
        const int es = tk & 7, dir = (tk >> 3) & 1, h = (tk >> 4) & 3, s = tk >> 6;
        const int nch = lat ? 32 : 2, tok_base = lat ? T_CTX + s * 4096 : s * 256, slot_base = lat ? 32 + s * 32 : s * 2;
        const float* pw = pwt + ((jr * 2 + dir) * 4 + h) * 132; const float gC = pw[128];
        f32x4 acc[2][4];
#pragma unroll
        for (int md = 0; md < 2; ++md)
#pragma unroll
            for (int ne = 0; ne < 4; ++ne) {
                if (lat) { const float* sp = inp(c, I_STATE) + ((size_t)(((s * 2 + jr) * 2 + dir) * 4 + h) * 256 + 32 * w + 8 * fq + 4 * md) * 512 + 64 * es + 16 * ne + fr;
                    acc[md][ne] = (f32x4){sp[0], sp[512], sp[1024], sp[1536]}; }
                else acc[md][ne] = (f32x4){0.f, 0.f, 0.f, 0.f}; }
        bf16x8 A0[2][4], A1[2][4]; u32x4 vraw[2];
        { const int c0 = dir ? nch - 1 : 0, c1 = dir ? nch - 2 : 1;
          __syncthreads();
          if (tid < 132) zl[tid] = pw[tid];
          R1_LOADV(vraw, tok_base + c0 * 128); R1_LOADA(A0, tok_base + c0 * 128);
          __syncthreads();
          R1_WRITEV(vraw, 0);
          R1_LOADV(vraw, tok_base + c1 * 128); R1_LOADA(A1, tok_base + c1 * 128); }
        for (int ci2 = 0; ci2 < nch; ci2 += 2) { R1_STEP(ci2, A0); R1_STEP(ci2 + 1, A1); }
        if (!lat) { float* op = c.out + (size_t)T * 1024 + ((size_t)(((s * 2 + jr) * 2 + dir) * 4 + h) * 256 + 32 * w + 8 * fq) * 512 + 64 * es + fr;
#pragma unroll
            for (int md = 0; md < 2; ++md)
#pragma unroll
                for (int ne = 0; ne < 4; ++ne)
#pragma unroll
                    for (int r = 0; r < 4; ++r) __builtin_nontemporal_store(acc[md][ne][r], op + (size_t)(4 * md + r) * 512 + 16 * ne); }
    }
}
__device__ __forceinline__ void phase_r2(const Ctx& c, int jr) {
    LAS unsigned char* lds = c.lds;
    LAS unsigned char* Pm = lds;
    LAS unsigned char* Ab = lds + 34816;
    LAS unsigned char* Bb = lds + 34816 + 2 * 18432;
    LAS float* pwl = (LAS float*)(lds + 34816 + 2 * 18432 + 2 * 36864);
    const bf16_t* Qg = (const bf16_t*)(c.ws + WS_Q); const bf16_t* Kg = (const bf16_t*)(c.ws + WS_K); const bf16_t* VTg = (const bf16_t*)(c.ws + WS_VT);
    const bf16_t* sb = (const bf16_t*)(c.ws + WS_SBUF); const float* pwt = (const float*)(c.ws + WS_TAB + TAB_POW); bf16_t* Og = (bf16_t*)(c.ws + WS_O);
    const int tid = c.tid, w = c.wave, lane = c.lane, fr = lane & 15, fq = lane >> 4, wi = w >> 2, wj = w & 3;
    for (int task0 = c.bid; task0 < 768; task0 += c.G) {
        int task = task0;
        if (c.G == 256) task = ((((task0 >> 8) * 128) + ((c.bid >> 4) << 3 | (c.bid & 7))) << 1) | ((c.bid >> 3) & 1);
        const int eh = task & 1, h = (task >> 1) & 3, slot = task >> 3, tok0 = slot * 128;
        const bool lat = slot >= 32; const bool has_f = lat || (slot & 1) == 1, has_b = lat || (slot & 1) == 0;
        const bf16_t* qrow = Qg + (size_t)tok0 * 1024 + h * 256; const bf16_t* krow = Kg + (size_t)tok0 * 1024 + h * 256;
        const bf16_t* vrow = VTg + (size_t)(h * 512 + eh * 256) * T + tok0;
        const bf16_t* sgf = sb + sbuf_index(slot, h, 0) * 131072; const bf16_t* sgb = sb + sbuf_index(slot, h, 1) * 131072;
        u32x4 RA[6], RB[6];
        const int r16 = tid >> 3, c16 = tid & 7, l16 = r16 * 144 + c16 * 16;
        const int ln = tid & 63, wq = tid >> 6;
        const int soff = ((((4 * eh + (wq >> 3)) * 8 + (wq & 1)) * 4 + ((wq >> 1) & 3)) * 64 + ln) * 8;
        const int NT = 6 + (has_f ? 4 : 0) + (has_b ? 4 : 0);
#define R2_TILE(n) ((n) < 6 ? (n) : (has_f ? (n) : (n) + 4))
#define R2_LOAD_P(t_, R) do { _Pragma("unroll") for (int i = 0; i < 2; ++i) { R[i] = *(const u32x4*)(qrow + (size_t)(r16 + 64 * i) * 1024 + (t_) * 64 + c16 * 8); R[2 + i] = *(const u32x4*)(krow + (size_t)(r16 + 64 * i) * 1024 + (t_) * 64 + c16 * 8); } } while (0)
#define R2_LOAD_V(t_, R) do { _Pragma("unroll") for (int i = 0; i < 4; ++i) R[i] = *(const u32x4*)(vrow + (size_t)(r16 + 64 * i) * T + ((t_) - 4) * 64 + c16 * 8); } while (0)
#define R2_LOAD_S(tile, R) do { const int t_ = (tile); const int kd = (t_ - 6) & 3; const bf16_t* sg = (t_ >= 10 ? sgb : sgf) + soff + (size_t)kd * 4096; \
        _Pragma("unroll") for (int i = 0; i < 4; ++i) R[i] = *(const u32x4*)(sg + (size_t)i * 16384); \
        _Pragma("unroll") for (int i = 0; i < 2; ++i) R[4 + i] = *(const u32x4*)(qrow + (size_t)(r16 + 64 * i) * 1024 + kd * 64 + c16 * 8); } while (0)
#define R2_WRITE_P(R, buf) do { LAS unsigned char* A_ = Ab + (buf) * 18432; LAS unsigned char* B_ = Bb + (buf) * 36864; \
        _Pragma("unroll") for (int i = 0; i < 2; ++i) { *(LAS u32x4*)(A_ + l16 + i * 64 * 144) = R[i]; *(LAS u32x4*)(B_ + l16 + i * 64 * 144) = R[2 + i]; } } while (0)
#define R2_WRITE_V(R, buf) do { LAS unsigned char* B_ = Bb + (buf) * 36864; _Pragma("unroll") for (int i = 0; i < 4; ++i) *(LAS u32x4*)(B_ + l16 + i * 64 * 144) = R[i]; } while (0)
#define R2_WRITE_S(tile, R, buf) do { const int t_ = (tile); LAS unsigned char* A_ = Ab + (buf) * 18432; LAS unsigned char* B_ = Bb + (buf) * 36864; \
        _Pragma("unroll") for (int i = 0; i < 4; ++i) *(LAS u32x4*)(B_ + (wq + 8 * i) * 1024 + ln * 16) = R[i]; \
        _Pragma("unroll") for (int i = 0; i < 2; ++i) { const u32x4 v = R[4 + i]; \
            const float xi = t_ >= 10 ? pwl[132 + 128 - (r16 + 64 * i)] : pwl[r16 + 64 * i + 1]; u32x4 o; \
            o.x = cvt_pk_bf16(bf2f(v.x & 0xffffu) * xi, bf2f(v.x >> 16) * xi); o.y = cvt_pk_bf16(bf2f(v.y & 0xffffu) * xi, bf2f(v.y >> 16) * xi); \
            o.z = cvt_pk_bf16(bf2f(v.z & 0xffffu) * xi, bf2f(v.z >> 16) * xi); o.w = cvt_pk_bf16(bf2f(v.w & 0xffffu) * xi, bf2f(v.w >> 16) * xi); \
            *(LAS u32x4*)(A_ + l16 + i * 64 * 144) = o; } } while (0)
#define R2_MMA_P(cur) do { LAS unsigned char* A_ = Ab + (cur) * 18432; LAS unsigned char* B_ = Bb + (cur) * 36864; \
    _Pragma("unroll") for (int kk = 0; kk < 2; ++kk) { bf16x8 a[2], b[4]; \
        _Pragma("unroll") for (int mj = 0; mj < 2; ++mj) a[mj] = *(const LAS bf16x8*)(B_ + (32 * wj + 16 * mj + fr) * 144 + kk * 64 + fq * 16); \
        _Pragma("unroll") for (int ni = 0; ni < 4; ++ni) b[ni] = *(const LAS bf16x8*)(A_ + (64 * wi + 16 * ni + fr) * 144 + kk * 64 + fq * 16); \
        _Pragma("unroll") for (int mj = 0; mj < 2; ++mj) _Pragma("unroll") for (int ni = 0; ni < 4; ++ni) pacc[mj][ni] = MFMA16(a[mj], b[ni], pacc[mj][ni]); } } while (0)
#define R2_MMA_OS(cur, bptr, bstride) do { LAS unsigned char* B_ = Bb + (cur) * 36864; \
    _Pragma("unroll") for (int kk = 0; kk < 2; ++kk) { bf16x8 b[4]; \
        _Pragma("unroll") for (int ni = 0; ni < 4; ++ni) b[ni] = *(const LAS bf16x8*)((bptr) + (64 * wi + 16 * ni + fr) * (bstride) + kk * 64 + fq * 16); \
        _Pragma("unroll") for (int me = 0; me < 4; me += 2) { const bf16x8 a0 = *(const LAS bf16x8*)(B_ + ((4 * wj + me) * 2 + kk) * 1024 + lane * 16), a1 = *(const LAS bf16x8*)(B_ + ((4 * wj + me + 1) * 2 + kk) * 1024 + lane * 16); \
            _Pragma("unroll") for (int ni = 0; ni < 4; ++ni) oacc[me][ni] = MFMA16(a0, b[ni], oacc[me][ni]); \
            _Pragma("unroll") for (int ni = 0; ni < 4; ++ni) oacc[me + 1][ni] = MFMA16(a1, b[ni], oacc[me + 1][ni]); } } } while (0)
#define R2_MMA_O(cur, bptr, bstride) do { LAS unsigned char* B_ = Bb + (cur) * 36864; \
    _Pragma("unroll") for (int kk = 0; kk < 2; ++kk) { bf16x8 b[4]; \
        _Pragma("unroll") for (int ni = 0; ni < 4; ++ni) b[ni] = *(const LAS bf16x8*)((bptr) + (64 * wi + 16 * ni + fr) * (bstride) + kk * 64 + fq * 16); \
        _Pragma("unroll") for (int me = 0; me < 4; me += 2) { const bf16x8 a0 = *(const LAS bf16x8*)(B_ + (64 * wj + 16 * me + fr) * 144 + kk * 64 + fq * 16), a1 = *(const LAS bf16x8*)(B_ + (64 * wj + 16 * me + 16 + fr) * 144 + kk * 64 + fq * 16); \
            _Pragma("unroll") for (int ni = 0; ni < 4; ++ni) oacc[me][ni] = MFMA16(a0, b[ni], oacc[me][ni]); \
            _Pragma("unroll") for (int ni = 0; ni < 4; ++ni) oacc[me + 1][ni] = MFMA16(a1, b[ni], oacc[me + 1][ni]); } } } while (0)
        __syncthreads();
        { int t2 = tid; asm volatile("" : "+v"(t2));
          if (t2 < 264) { const int dd = t2 >= 132 ? 1 : 0, n = t2 - dd * 132; pwl[t2] = pwt[((jr * 2 + dd) * 4 + h) * 132 + n]; } }
        R2_LOAD_P(0, RA); R2_LOAD_P(1, RB); R2_WRITE_P(RA, 0); R2_LOAD_P(2, RA);
        __syncthreads();
        {
            f32x4 pacc[2][4];
#pragma unroll
            for (int a = 0; a < 2; ++a)
#pragma unroll
                for (int b = 0; b < 4; ++b) pacc[a][b] = (f32x4){0.f, 0.f, 0.f, 0.f};
            R2_WRITE_P(RB, 1); R2_LOAD_P(3, RB); R2_MMA_P(0); __syncthreads();
            R2_WRITE_P(RA, 0); R2_LOAD_V(4, RA); R2_MMA_P(1); __syncthreads();
            R2_WRITE_P(RB, 1); R2_LOAD_V(5, RB); R2_MMA_P(0); __syncthreads();
            R2_WRITE_V(RA, 0); if (NT > 6) R2_LOAD_S(R2_TILE(6), RA); R2_MMA_P(1);
#pragma unroll
            for (int mj = 0; mj < 2; ++mj)
#pragma unroll
                for (int ni = 0; ni < 4; ++ni) { const int i = 64 * wi + 16 * ni + fr, j0 = 32 * wj + 16 * mj + 4 * fq; float v[4];
#pragma unroll
                    for (int r = 0; r < 4; ++r) { const int df = i - (j0 + r); v[r] = pacc[mj][ni][r] * (df >= 0 ? pwl[df] : pwl[132 - df]); }
                    u32x2 o; o.x = cvt_pk_bf16(v[0], v[1]); o.y = cvt_pk_bf16(v[2], v[3]);
                    *(LAS u32x2*)(Pm + i * 272 + j0 * 2) = o; }
            __syncthreads();
        }
        f32x4 oacc[4][4];
#pragma unroll
        for (int a = 0; a < 4; ++a)
#pragma unroll
            for (int b = 0; b < 4; ++b) oacc[a][b] = (f32x4){0.f, 0.f, 0.f, 0.f};
        R2_WRITE_V(RB, 1); if (NT > 7) R2_LOAD_S(R2_TILE(7), RB); R2_MMA_O(0, Pm, 272); __syncthreads();
        if (NT > 6) R2_WRITE_S(R2_TILE(6), RA, 0); if (NT > 8) R2_LOAD_S(R2_TILE(8), RA); R2_MMA_O(1, Pm + 128, 272); __syncthreads();
        for (int n = 6; n < NT; n += 2) {
            if (n + 1 < NT) R2_WRITE_S(R2_TILE(n + 1), RB, 1); if (n + 3 < NT) R2_LOAD_S(R2_TILE(n + 3), RB); R2_MMA_OS(0, Ab, 144); __syncthreads();
            if (n + 2 < NT) R2_WRITE_S(R2_TILE(n + 2), RA, 0); if (n + 4 < NT) R2_LOAD_S(R2_TILE(n + 4), RA); R2_MMA_OS(1, Ab + 18432, 144); __syncthreads();
        }
        {
            int t3 = tid; asm volatile("" : "+v"(t3));
            LAS float* st = (LAS float*)Pm;
            LAS float* st2 = (LAS float*)(Pm + 4096);
            unsigned long long* gstats = (unsigned long long*)(c.ws + WS_MODP); unsigned* gflag = (unsigned*)(c.ws + WS_BAR + 16384);
            const unsigned epoch = (unsigned)jr + 1u;
#pragma unroll
            for (int ni = 0; ni < 4; ++ni) { float s1 = 0.f, s2 = 0.f;
#pragma unroll
                for (int me = 0; me < 4; ++me)
#pragma unroll
                    for (int r = 0; r < 4; ++r) { const float v = oacc[me][ni][r]; s1 += v; s2 += v * v; }
                s1 += __shfl_xor(s1, 16); s1 += __shfl_xor(s1, 32); s2 += __shfl_xor(s2, 16); s2 += __shfl_xor(s2, 32);
                if (fq == 0) { const int i = 64 * wi + 16 * ni + fr; st[(i * 4 + wj) * 2] = s1; st[(i * 4 + wj) * 2 + 1] = s2; } }
            __syncthreads();
            u32x2 gq[4][4]; f32x4 gnv[4];
            const bf16_t* Gg = (const bf16_t*)(c.ws + WS_G); const float* gnw = inp(c, I_GNW) + (jr * 4 + h) * 512 + eh * 256 + 64 * wj + 4 * fq;
#pragma unroll
            for (int me = 0; me < 4; ++me) { gnv[me] = *(const f32x4*)(gnw + 16 * me);
#pragma unroll
                for (int ni = 0; ni < 4; ++ni) gq[me][ni] = *(const u32x2*)(Gg + (size_t)(tok0 + 64 * wi + 16 * ni + fr) * 2048 + h * 512 + eh * 256 + 64 * wj + 16 * me + 4 * fq); }
            float p1 = 0.f, p2 = 0.f;
            if (t3 < 128) {
#pragma unroll
                for (int q = 0; q < 4; ++q) { p1 += st[(t3 * 4 + q) * 2]; p2 += st[(t3 * 4 + q) * 2 + 1]; }
                const unsigned long long pk = (unsigned long long)__builtin_bit_cast(unsigned, p1) | ((unsigned long long)__builtin_bit_cast(unsigned, p2) << 32);
                __hip_atomic_store(gstats + (size_t)task * 128 + t3, pk, __ATOMIC_RELAXED, __HIP_MEMORY_SCOPE_AGENT); }
            asm volatile("s_waitcnt vmcnt(0)" ::: "memory");
            __syncthreads();
            if (t3 == 0) {
                __hip_atomic_store(gflag + task, epoch, __ATOMIC_RELAXED, __HIP_MEMORY_SCOPE_AGENT);
                unsigned sp = 0;
                while (__hip_atomic_load(gflag + (task ^ 1), __ATOMIC_RELAXED, __HIP_MEMORY_SCOPE_AGENT) != epoch) { __builtin_amdgcn_s_sleep(2); if (++sp > (1u << 20)) break; }
                __builtin_amdgcn_fence(__ATOMIC_ACQUIRE, "agent");
                asm volatile("s_waitcnt vmcnt(0)" ::: "memory"); }
            __syncthreads();
            if (t3 < 128) {
                const unsigned long long q = __hip_atomic_load(gstats + (size_t)(task ^ 1) * 128 + t3, __ATOMIC_RELAXED, __HIP_MEMORY_SCOPE_AGENT);
                const float S1 = p1 + __builtin_bit_cast(float, (unsigned)(q & 0xffffffffull)), S2 = p2 + __builtin_bit_cast(float, (unsigned)(q >> 32));
                const float mu = S1 * (1.f / 512.f), var = fmaxf(S2 * (1.f / 512.f) - mu * mu, 0.f);
                st2[t3 * 2] = mu; st2[t3 * 2 + 1] = rsqrtf(var + GN_EPS); }
            __syncthreads();
            bf16_t* Ag = (bf16_t*)(c.ws + WS_A);
#pragma unroll
            for (int ni = 0; ni < 4; ++ni) { const int i = 64 * wi + 16 * ni + fr; const float mu = st2[i * 2], rs = st2[i * 2 + 1];
#pragma unroll
                for (int me = 0; me < 4; ++me) { const u32x2 gb = gq[me][ni];
                    const float g0 = bf2f(gb.x & 0xffffu), g1 = bf2f(gb.x >> 16), g2 = bf2f(gb.y & 0xffffu), g3 = bf2f(gb.y >> 16);
                    const f32x4 o = (oacc[me][ni] - mu) * rs * gnv[me];
                    u32x2 w; w.x = cvt_pk_bf16(silu_f(g0) * o[0], silu_f(g1) * o[1]); w.y = cvt_pk_bf16(silu_f(g2) * o[2], silu_f(g3) * o[3]);
                    *(u32x2*)(Ag + (size_t)(tok0 + i) * 2048 + h * 512 + eh * 256 + 64 * wj + 16 * me + 4 * fq) = w; } }
        }
    }
}
__device__ __forceinline__ void phase_gate(const Ctx& c, int jr) {
    const bf16_t* Og = (const bf16_t*)(c.ws + WS_O); const bf16_t* Gg = (const bf16_t*)(c.ws + WS_G); bf16_t* Ag = (bf16_t*)(c.ws + WS_A);
    const float* gnw = inp(c, I_GNW) + jr * 4 * 512;
    for (int it0 = c.gw; it0 < T * 4; it0 += 4 * c.ngw) {
        u32x2 ob[4][2], gb[4][2];
#pragma unroll
        for (int k = 0; k < 4; ++k) { const int it = min(it0 + k * c.ngw, T * 4 - 1); const size_t base = (size_t)(it >> 2) * 2048 + (it & 3) * 512;
#pragma unroll
            for (int j = 0; j < 2; ++j) { ob[k][j] = *(const u32x2*)(Og + base + 4 * c.lane + 256 * j); gb[k][j] = *(const u32x2*)(Gg + base + 4 * c.lane + 256 * j); } }
#pragma unroll
        for (int k = 0; k < 4; ++k) { const int it = it0 + k * c.ngw; if (it < T * 4) { const int h = it & 3; const size_t base = (size_t)(it >> 2) * 2048 + h * 512;
            f32x4 v[2]; float s = 0.f;
#pragma unroll
            for (int j = 0; j < 2; ++j) { v[j] = (f32x4){bf2f(ob[k][j].x & 0xffffu), bf2f(ob[k][j].x >> 16), bf2f(ob[k][j].y & 0xffffu), bf2f(ob[k][j].y >> 16)}; s += (v[j][0] + v[j][1]) + (v[j][2] + v[j][3]); }
            const float mu = wave_sum(s) * (1.f / 512.f); float q = 0.f;
#pragma unroll
            for (int j = 0; j < 2; ++j) { v[j] = v[j] - mu; q += (v[j][0] * v[j][0] + v[j][1] * v[j][1]) + (v[j][2] * v[j][2] + v[j][3] * v[j][3]); }
            const float rstd = rsqrtf(wave_sum(q) * (1.f / 512.f) + GN_EPS);
#pragma unroll
            for (int j = 0; j < 2; ++j) { const int col = 4 * c.lane + 256 * j; const f32x4 gw = *(const f32x4*)(gnw + h * 512 + col);
                const float g0 = bf2f(gb[k][j].x & 0xffffu), g1 = bf2f(gb[k][j].x >> 16), g2 = bf2f(gb[k][j].y & 0xffffu), g3 = bf2f(gb[k][j].y >> 16);
                const f32x4 o = v[j] * rstd * gw;
                u32x2 w; w.x = cvt_pk_bf16(silu_f(g0) * o[0], silu_f(g1) * o[1]); w.y = cvt_pk_bf16(silu_f(g2) * o[2], silu_f(g3) * o[3]);
                *(u32x2*)(Ag + base + col) = w; } } }
    }
}

#ifndef MULTI_LAUNCH
#define MULTI_LAUNCH 0
#endif
#define PH_ON (ph >= p.ph_lo && ph < p.ph_hi)
#define FRESH const Ctx c = fresh_ctx(&p, lds, bar.w0); unsigned char* const ws = c.ws; const int G = c.G; const float* const mod = (const float*)(ws + WS_MOD); (void)G; (void)mod
#ifndef SYNC_REP
#define SYNC_REP 1
#endif
#ifndef REP_R1
#define REP_R1 1
#endif
#ifndef REP_R2
#define REP_R2 1
#endif
#ifndef REP_LIGHT
#define REP_LIGHT 1
#endif
#ifndef REP_POOL
#define REP_POOL 1
#endif
#ifndef REP_NORM
#define REP_NORM 1
#endif
#ifndef REP_TR
#define REP_TR 1
#endif
#ifndef REP_GATE
#define REP_GATE 1
#endif
#ifndef REP_P0
#define REP_P0 1
#endif
#ifndef REP_P0C
#define REP_P0C 1
#endif
#ifndef REP_GEMM_IN
#define REP_GEMM_IN 1
#endif
#ifndef REP_GEMM_UP
#define REP_GEMM_UP 1
#endif
#ifndef REP_GEMM_DOWN
#define REP_GEMM_DOWN 1
#endif
#ifndef REP_GEMM
#define REP_GEMM 1
#endif
#define PH_END do { ++ph; if (ph > p.ph_lo && ph < p.ph_hi) { for (int r_ = 0; r_ < SYNC_REP; ++r_) xcd_barrier(bar); } } while (0)
template <class Sched> __device__ __forceinline__ void stage_rstd_bias(const Ctx& c, const Sched& S, const float* rowss, const float* bias, int ldb) {
    LAS float* tab = (LAS float*)(c.lds + 132 * 1024);
    pg8::Unit u;
    for (int i = 0; i < 8 && S.next(i, u); ++i) {
        if (c.tid < 256) { const f32x4* rp = (const f32x4*)(rowss + (size_t)(u.pm * 256 + c.tid) * 16); const f32x4 a = rp[0] + rp[1] + rp[2] + rp[3];
            tab[i * 512 + c.tid] = rsqrtf(((a[0] + a[1]) + (a[2] + a[3])) * (1.f / 1024.f) + NORM_EPS); }
        else { const int cvv = u.pm < 16 ? 0 : (u.pm < 32 ? 1 : 2); tab[i * 512 + c.tid] = bias[(size_t)cvv * ldb + u.pn * 256 + (c.tid - 256)]; }
    }
    __syncthreads();
}
template <class Sched> __device__ __forceinline__ void stage_res_vectors(const Ctx& c, const Sched& S, const float* gate, int nh, const float* nw, const float* sc) {
    LAS float* tab = (LAS float*)(c.lds + 132 * 1024);
    pg8::Unit u;
    for (int i = 0; i < 2 && S.next(i, u); ++i)
        for (int idx = c.tid; idx < 1536; idx += NTHREADS) { const int which = idx >= 768 ? 1 : 0, r = idx - which * 768, cvv = r >> 8, col = u.pn * 256 + (r & 255);
            tab[i * 1536 + idx] = which == 0 ? gate[(size_t)cvv * NMOD + col] : (nh ? nw[col] * (1.f + sc[(size_t)cvv * NMOD + col]) : 0.f); }
    __syncthreads();
}
template <int l> __device__ __forceinline__ void run_layer(const Params& p, LAS unsigned char* const lds, const XcdBarrier& bar, int& ph) {
        const int j2 = l >> 1;
        if ((l & 1) == 0) {
            if (PH_ON) { for (int r_ = 0; r_ < REP_NORM; ++r_) { FRESH; if (l == 0) bias_finalize(c); phase_norm<1>(c, l, 0, l == 0); } }
            PH_END;
            if (PH_ON) { for (int r_ = 0; r_ < REP_POOL; ++r_) { FRESH; phase_pool_v(c); } }
            PH_END;
            if (PH_ON) { for (int r_ = 0; r_ < REP_POOL; ++r_) { FRESH; phase_pool_h(c); } }
            PH_END;
            if (PH_ON) { FRESH;
                pg8::Gemm g{(const bf16_t*)(ws + WS_DBUF), (const bf16_t*)(ws + WS_PWT) + (size_t)j2 * 262144, 4 * T, 1024, 256};
                pg8::PoolOrder S{G, c.bid};
                pg8::EpiPool E{(float*)(ws + WS_X), inp(c, I_XP), inp(c, I_XS), l == 0 ? 1 : 0, mod + (size_t)(l * 3) * NMOD + 2 * 1024, inp(c, I_PB) + j2 * 1024, inp(c, I_PS) + j2 * 1024,
                                inp(c, I_NMLP) + l * 1024, mod + (size_t)(l * 3) * NMOD + 4 * 1024, (bf16_t*)(ws + WS_HB), (float*)(ws + WS_ROWSS)};
                pg8::gemm_phase<pg8::EpiPool, pg8::PoolOrder, true, true>(c.lds, g, S, E, c.tid);
            }
            PH_END;
        } else {
            if (PH_ON) { FRESH;
                pg8::Gemm g{(const bf16_t*)(ws + WS_HB), (const bf16_t*)(ws + WS_WINT) + (size_t)j2 * RIN * 1024, T, RIN, 1024};
                pg8::EpiInproj E{(bf16_t*)(ws + WS_Q), (bf16_t*)(ws + WS_K), (bf16_t*)(ws + WS_V), (bf16_t*)(ws + WS_G), (const float*)(ws + WS_TAB + TAB_ROPE), (const LAS float*)(c.lds + 132 * 1024), 0};
                if (G == 256) { pg8::InprojOrder S; S.init(G, c.bid);
                    stage_rstd_bias(c, S, (const float*)(ws + WS_ROWSS), (const float*)(ws + WS_BIASI) + (size_t)j2 * 3 * RIN, RIN);
                    pg8::gemm_phase<pg8::EpiInproj, pg8::InprojOrder, true, true>(c.lds, g, S, E, c.tid); }
                else { pg8::StaticOrder S; S.init(T, RIN, G, c.bid);
                    stage_rstd_bias(c, S, (const float*)(ws + WS_ROWSS), (const float*)(ws + WS_BIASI) + (size_t)j2 * 3 * RIN, RIN);
                    pg8::gemm_phase<pg8::EpiInproj, pg8::StaticOrder, true, true>(c.lds, g, S, E, c.tid); }
            }
            PH_END;
            if (PH_ON) { for (int r_ = 0; r_ < REP_TR; ++r_) { FRESH; phase_tr(c); } }
            PH_END;
            if (PH_ON) { for (int r_ = 0; r_ < REP_R1; ++r_) { FRESH; phase_r1(c, j2); }
                { FRESH;
                  if (G == 256 && c.bid >= 128) { const int idx = c.bid - 128;
                    __syncthreads();
                    pg8::Gemm g{(const bf16_t*)(ws + WS_HB), (const bf16_t*)(ws + WS_WINT) + (size_t)j2 * RIN * 1024, T, RIN, 1024};
                    pg8::SingleOrder S{idx & 15, 16 + (idx >> 4)};
                    pg8::EpiInproj E{(bf16_t*)(ws + WS_Q), (bf16_t*)(ws + WS_K), (bf16_t*)(ws + WS_V), (bf16_t*)(ws + WS_G), (const float*)(ws + WS_TAB + TAB_ROPE), (const LAS float*)(c.lds + 132 * 1024), 0};
                    stage_rstd_bias(c, S, (const float*)(ws + WS_ROWSS), (const float*)(ws + WS_BIASI) + (size_t)j2 * 3 * RIN, RIN);
                    pg8::gemm_phase<pg8::EpiInproj, pg8::SingleOrder, true, true>(c.lds, g, S, E, c.tid); } } }
            PH_END;
            if (PH_ON) { for (int r_ = 0; r_ < REP_R2; ++r_) { FRESH; phase_r2(c, j2); } }
            PH_END;
            if (PH_ON) { FRESH;
                pg8::Gemm g{(const bf16_t*)(ws + WS_A), (const bf16_t*)(ws + WS_WOUTT) + (size_t)j2 * 1024 * HV, T, 1024, HV};
                pg8::StaticOrder S; S.init(T, 1024, G, c.bid); S.nM = T / 192; S.nwg = S.nM * S.nN;
                pg8::EpiRes192 E{(float*)(ws + WS_X), 1, (bf16_t*)(ws + WS_HB), (float*)(ws + WS_ROWSS), (const LAS float*)(c.lds + 132 * 1024), 0};
                stage_res_vectors(c, S, mod + (size_t)(l * 3) * NMOD + 2 * 1024, 1, inp(c, I_NMLP) + l * 1024, mod + (size_t)(l * 3) * NMOD + 4 * 1024);
                pg8::gemm_phase<pg8::EpiRes192, pg8::StaticOrder, true, true, 3>(c.lds, g, S, E, c.tid);
            }
            PH_END;
        }
        if (PH_ON) { FRESH;
            pg8::Gemm g{(const bf16_t*)(ws + WS_HB), (const bf16_t*)(ws + WS_W1T) + (size_t)l * 4096 * 1024, T, FF, 1024};
            pg8::StaticOrder S; S.init(T, FF, G, c.bid);
            pg8::EpiUp E{(bf16_t*)(ws + WS_H), (const LAS float*)(c.lds + 132 * 1024), 0};
            stage_rstd_bias(c, S, (const float*)(ws + WS_ROWSS), (const float*)(ws + WS_BIASU) + (size_t)l * 3 * 4096, 4096);
            for (int r_ = 0; r_ < REP_GEMM_UP; ++r_) { E.ord = 0; pg8::gemm_phase<pg8::EpiUp, pg8::StaticOrder, true, true>(c.lds, g, S, E, c.tid); }
        }
        PH_END;
        if (PH_ON) { FRESH;
            pg8::Gemm g{(const bf16_t*)(ws + WS_H), (const bf16_t*)(ws + WS_W2T) + (size_t)l * 1024 * 4096, T, 1024, FF};
            pg8::StaticOrder S; S.init(T, 1024, G, c.bid); S.nM = T / 192; S.nwg = S.nM * S.nN;
            pg8::EpiRes192 E{(float*)(ws + WS_X), (l & 1) == 0 ? 1 : 0, (bf16_t*)(ws + WS_HB), (float*)(ws + WS_ROWSS), (const LAS float*)(c.lds + 132 * 1024), 0};
            stage_res_vectors(c, S, mod + (size_t)(l * 3) * NMOD + 5 * 1024, (l & 1) == 0 ? 1 : 0, inp(c, I_NMIX) + ((l + 1) & 3) * 1024, mod + (size_t)(((l + 1) & 3) * 3) * NMOD + 1 * 1024);
            for (int r_ = 1; r_ < REP_GEMM_DOWN; ++r_) { pg8::EpiRes192 E2{(float*)(ws + WS_O), 0, (bf16_t*)(ws + WS_HB), (float*)(ws + WS_ROWSS), (const LAS float*)(c.lds + 132 * 1024), 0}; pg8::gemm_phase<pg8::EpiRes192, pg8::StaticOrder, true, true, 3>(c.lds, g, S, E2, c.tid); }
            pg8::gemm_phase<pg8::EpiRes192, pg8::StaticOrder, true, true, 3>(c.lds, g, S, E, c.tid);
        }
        PH_END;
    }
constexpr int N_PHASES = 3 + 2 * 6 + 2 * 7 + 1;
__global__ void __launch_bounds__(NTHREADS) fwd_megakernel(Params p) {
    extern __shared__ __attribute__((aligned(16))) unsigned char lds_raw[];
    cg::grid_group grid = cg::this_grid();
    LAS unsigned char* const lds = (LAS unsigned char*)lds_raw;
    if (p.ph_hi < 0) grid.sync();
    volatile LAS unsigned* const bst = (volatile LAS unsigned*)(lds + LDS_BAR_OFF);
    if (threadIdx.x < 4) bst[threadIdx.x] = 0u;
    __syncthreads();
    XcdBarrier bar = xcd_barrier_post((unsigned*)(p.ws + WS_BAR), bst);
    bar.w0 = __builtin_amdgcn_readfirstlane((int)threadIdx.x >> 6);
    int ph = 0;
    if (PH_ON) { for (int r_ = 0; r_ < REP_P0; ++r_) { FRESH; phase_p0(c); } }
    PH_END;
    if (PH_ON) { FRESH; phase_p0b(c); }
    PH_END;
    if (PH_ON) { for (int r_ = 0; r_ < REP_P0C; ++r_) { FRESH; phase_p0c(c); } }
    PH_END;
    run_layer<0>(p, lds, bar, ph); run_layer<1>(p, lds, bar, ph); run_layer<2>(p, lds, bar, ph); run_layer<3>(p, lds, bar, ph);
    if (PH_ON) { FRESH; phase_norm<2>(c, 0, 0, 0); }
}

extern "C" void kernel_launch(void* const* d_in, const int* in_sizes, int n_in, void* d_out, int out_size, void* d_ws, size_t ws_size, hipStream_t stream) {
    static int grid = 0;
    if (grid == 0) {
        if (n_in != 19 || ws_size < WS_END) { fprintf(stderr, "kernel_launch: unexpected n_in %d / ws_size %zu\n", n_in, ws_size); grid = -1; return; }
        int dev = 0, cus = 0, per_cu = 0;
        hipGetDevice(&dev); hipDeviceGetAttribute(&cus, hipDeviceAttributeMultiprocessorCount, dev);
        if (hipFuncSetAttribute((const void*)fwd_megakernel, hipFuncAttributeMaxDynamicSharedMemorySize, LDS_BYTES) != hipSuccess) { fprintf(stderr, "kernel_launch: hipFuncSetAttribute failed\n"); grid = -1; return; }
        if (hipOccupancyMaxActiveBlocksPerMultiprocessor(&per_cu, (const void*)fwd_megakernel, NTHREADS, LDS_BYTES) != hipSuccess || per_cu < 1) { fprintf(stderr, "kernel_launch: occupancy query says %d\n", per_cu); per_cu = 1; }
        (void)hipGetLastError();
        grid = cus;
    }
    if (grid < 0) return;
    if (hipMemsetAsync((char*)d_ws + WS_BAR, 0, 16384 + 4096, stream) != hipSuccess) { fprintf(stderr, "kernel_launch: memset of barrier words failed\n"); return; }
    Params p{};
    for (int i = 0; i < 19; ++i) p.in[i] = (const float*)d_in[i];
    p.out = (float*)d_out; p.ws = (unsigned char*)d_ws;
#if MULTI_LAUNCH
    for (int k = 0; k < N_PHASES; ++k) { p.ph_lo = k; p.ph_hi = k + 1; hipLaunchKernelGGL(fwd_megakernel, dim3(grid), dim3(NTHREADS), LDS_BYTES, stream, p); }
#else
    p.ph_lo = 0; p.ph_hi = N_PHASES;
    void* args[] = {&p};
    hipError_t e = hipLaunchCooperativeKernel((const void*)fwd_megakernel, dim3(grid), dim3(NTHREADS), args, LDS_BYTES, stream);
    if (e != hipSuccess) fprintf(stderr, "kernel_launch: cooperative launch failed: %s (grid %d)\n", hipGetErrorString(e), grid);
#endif
}
```

```cpp
#include <hip/hip_runtime.h>
#include <hip/hip_cooperative_groups.h>
#include <cstdio>
#include <cstdint>
namespace cg = cooperative_groups;

#define LAS __attribute__((address_space(3)))
typedef unsigned short bf16_t;
typedef short bf16x8 __attribute__((ext_vector_type(8)));
typedef float f32x4 __attribute__((ext_vector_type(4)));
typedef float f32x2 __attribute__((ext_vector_type(2)));
typedef unsigned u32x4 __attribute__((ext_vector_type(4)));
typedef unsigned u32x2 __attribute__((ext_vector_type(2)));

constexpr int D = 1024, FF = 4096, T_CTX = 4096, T = 12288, RIN = 6144, HV = 2048, NMOD = 6144;
constexpr float NORM_EPS = 1e-6f, GN_EPS = 1e-5f;
constexpr int NWAVES = 8, NTHREADS = 512;
constexpr size_t MiB = 1u << 20;
constexpr size_t WS_W1T = 0, WS_W2T = 32 * MiB, WS_WINT = 64 * MiB, WS_WOUTT = 88 * MiB, WS_PWT = 96 * MiB, WS_MODP = 97 * MiB, WS_MOD = 102 * MiB,
                 WS_TAB = 103 * MiB, WS_X = 104 * MiB, WS_HB = 152 * MiB, WS_Q = 176 * MiB, WS_K = 200 * MiB, WS_V = 224 * MiB, WS_G = 272 * MiB,
                 WS_O = 320 * MiB, WS_VT = 416 * MiB, WS_SBUF = 464 * MiB, WS_END = 624 * MiB;
constexpr size_t WS_KT = WS_O + 48 * MiB  , WS_DBUF = WS_G, WS_A = WS_O, WS_HF32 = WS_O, WS_VS = WS_O + 48 * MiB, WS_H = WS_SBUF;
constexpr size_t WS_BAR = WS_MOD + 512 * 1024;
constexpr size_t WS_ROWSS = WS_TAB + 128 * 1024;
constexpr size_t WS_BIASP = WS_VS, WS_BIASU = WS_MOD + 528 * 1024, WS_BIASI = WS_BIASU + 4 * 3 * 4096 * 4;
constexpr size_t TAB_ROPE = 0, TAB_POW = 65536;
constexpr int LDS_BYTES = 151 * 1024, LDS_BAR_OFF = 150 * 1024;

struct Params { const float* in[19]; float* out; unsigned char* ws; int ph_lo, ph_hi; };
enum { I_XP = 0, I_XS, I_STATE, I_C, I_CCTX, I_WADA, I_BADA, I_NMIX, I_NMLP, I_PW, I_PB, I_PS, I_WIN, I_DECAY, I_GNW, I_WOUT, I_W1, I_W2, I_FNW };

__device__ __forceinline__ int tid_from_wave(int wave0) { return wave0 * 64 + (int)__builtin_amdgcn_mbcnt_hi(~0u, __builtin_amdgcn_mbcnt_lo(~0u, 0u)); }
__device__ __forceinline__ float bf2f(unsigned h) { return __builtin_bit_cast(float, h << 16); }
__device__ __forceinline__ unsigned cvt_pk_bf16(float lo, float hi) { unsigned r; asm volatile("v_cvt_pk_bf16_f32 %0, %1, %2" : "=v"(r) : "v"(lo), "v"(hi)); return r; }
__device__ __forceinline__ float wave_sum(float v) {
#pragma unroll
    for (int o = 1; o < 64; o <<= 1) v += __shfl_xor(v, o);
    return v;
}
__device__ __forceinline__ float silu_f(float v) { return v / (1.f + __expf(-v)); }
__device__ __forceinline__ int perm8(int L) { return (L & ~31) | (((L >> 2) & 1) << 4) | (((L >> 3) & 3) << 2) | (L & 3); }
__device__ __forceinline__ int permrope(int L) { return (L & ~127) | (((L >> 4) & 3) << 5) | (((L >> 6) & 1) << 4) | (L & 15); }
__device__ __forceinline__ int cv_of_row(int row) { return row < T_CTX ? 0 : 1 + ((row - T_CTX) >> 12); }

namespace pg8 {
#define PG8_LAS __attribute__((address_space(3)))
typedef unsigned short bf16_t;
typedef short bf16x8 __attribute__((ext_vector_type(8)));
typedef float f32x4 __attribute__((ext_vector_type(4)));
typedef unsigned u32x4 __attribute__((ext_vector_type(4)));
constexpr int BM = 256, BK = 64, HALF = 128, HTB = HALF * BK * 2  , STAGE_BYTES = 8 * HTB, NXCD = 8, WGM = 8;

__host__ __device__ __forceinline__ int lds_byte(int r, int c) { const int st = (r >> 4) * 2 + (c >> 5), rr = r & 15, cc = c & 31, ob = rr * 64 + cc * 2; return st * 1024 + (ob ^ (((ob >> 9) & 1) << 5)); }
__host__ __device__ __forceinline__ void stage_rc(int b, int& R, int& C) { const int st = b / 1024, sb = b % 1024, swz = sb ^ (((sb >> 9) & 1) << 5); R = (st >> 1) * 16 + swz / 64; C = (st & 1) * 32 + (swz % 64) / 2; }
__host__ __device__ __forceinline__ int perm32(int rho) { const int n = rho >> 4, i = rho & 15; return 8 * (i >> 2) + 4 * n + (i & 3); }

struct Unit { int pm, pn; };
struct Gemm { const bf16_t* A; const bf16_t* Bt; int M, N, K; };

struct StaticOrder {
    int nM, nN, nwg, G, c;
    __host__ __device__ void init(int M, int N, int G_, int c_) { nM = M / BM; nN = N / BM; nwg = nM * nN; G = G_; c = c_; }
    __host__ __device__ bool next(int i, Unit& u) const {
        const long L = (long)i * G + c; if (L >= nwg) return false;
        int wgid = (int)L; { const int q = nwg / NXCD, r = nwg % NXCD, xcd = wgid % NXCD, off = wgid / NXCD; wgid = (xcd < r ? xcd * (q + 1) : r * (q + 1) + (xcd - r) * q) + off; }
        const int nig = WGM * nN, gid = wgid / nig, fm = gid * WGM, gsz = (nM - fm) < WGM ? (nM - fm) : WGM;
        u.pm = fm + ((wgid % nig) % gsz); u.pn = (wgid % nig) / gsz; return true;
    }
    __device__ __forceinline__ void a_ready(const Unit&) const {}
    __device__ __forceinline__ void done(const Unit&) const {}
};

__device__ __forceinline__ unsigned cvt_pk_bf16(float lo, float hi) { unsigned r; asm volatile("v_cvt_pk_bf16_f32 %0, %1, %2" : "=v"(r) : "v"(lo), "v"(hi)); return r; }

struct PoolOrder {
    int G, c;
    __device__ bool next(int i, Unit& u) const { const long L = (long)i * G + c; if (L >= 192) return false; u.pm = (int)L; u.pn = (int)L / 48; return true; }
    __device__ __forceinline__ void a_ready(const Unit&) const {}
    __device__ __forceinline__ void done(const Unit&) const {}
};
struct InprojOrder {
    StaticOrder L, C; int G, c;
    __device__ void init(int G_, int c_) { G = G_; c = c_; L.init(8192, 6144, G_, c_); C.init(4096, 4096, G_, c_); }
    __device__ bool next(int i, Unit& u) const { const long id = (long)i * G + c; if (id >= 1024) return false;
        if (id < 768) { StaticOrder t = L; t.c = (int)(id % G); if (!t.next((int)(id / G), u)) return false; u.pm += 16; return true; }
        const long k = id - 768; StaticOrder t = C; t.c = (int)(k % G); return t.next((int)(k / G), u); }
    __device__ __forceinline__ void a_ready(const Unit&) const {}
    __device__ __forceinline__ void done(const Unit&) const {}
};
struct SingleOrder { int pm, pn;
    __device__ bool next(int i, Unit& u) const { if (i > 0) return false; u.pm = pm; u.pn = pn; return true; }
    __device__ __forceinline__ void a_ready(const Unit&) const {}
    __device__ __forceinline__ void done(const Unit&) const {}
};
struct EpiUp {
    static constexpr bool PERM = false, AFTER_DRAIN = false;
    bf16_t* H; const PG8_LAS float* tab; mutable int ord;
    __device__ __forceinline__ void operator()(const f32x4 (&acc)[2][2][4][2], const Unit& u, int wr, int wc, int fr, int fq) const {
        const int row0 = u.pm * BM + wr * 64 + fr, col0 = u.pn * BM + wc * 32 + 8 * fq;
        const PG8_LAS float* rt = tab + ord * 512 + wr * 64 + fr; const PG8_LAS float* bt = tab + ord * 512 + 256 + wc * 32 + 8 * fq; ++ord;
#pragma unroll
        for (int bj = 0; bj < 2; ++bj) { const f32x4 b0 = *(const PG8_LAS f32x4*)(bt + bj * HALF), b1 = *(const PG8_LAS f32x4*)(bt + bj * HALF + 4);
#pragma unroll
            for (int ai = 0; ai < 2; ++ai)
#pragma unroll
                for (int m = 0; m < 4; ++m) { const float rs = rt[ai * HALF + m * 16]; f32x4 v0 = acc[ai][bj][m][0] * rs + b0, v1 = acc[ai][bj][m][1] * rs + b1;
#pragma unroll
                    for (int j = 0; j < 4; ++j) { const float a = fmaxf(v0[j], 0.f), b = fmaxf(v1[j], 0.f); v0[j] = a * a; v1[j] = b * b; }
                    u32x4 w; w.x = cvt_pk_bf16(v0[0], v0[1]); w.y = cvt_pk_bf16(v0[2], v0[3]); w.z = cvt_pk_bf16(v1[0], v1[1]); w.w = cvt_pk_bf16(v1[2], v1[3]);
                    *(u32x4*)(H + (size_t)(row0 + ai * HALF + m * 16) * 4096 + col0 + bj * HALF) = w; } }
    }
};
struct EpiRes {
    static constexpr bool PERM = false, AFTER_DRAIN = false;
    float* X; const float* gate;
    __device__ __forceinline__ void operator()(const f32x4 (&acc)[2][2][4][2], const Unit& u, int wr, int wc, int fr, int fq) const {
        const int row0 = u.pm * BM + wr * 64 + fr, col0 = u.pn * BM + wc * 32 + 8 * fq;
        const int cv = u.pm < 16 ? 0 : (u.pm < 32 ? 1 : 2);
#pragma unroll
        for (int bj = 0; bj < 2; ++bj)
#pragma unroll
            for (int n = 0; n < 2; ++n) {
                const int co = col0 + bj * HALF + 4 * n;
                const f32x4 gv = *(const f32x4*)(gate + cv * 6144 + co);
#pragma unroll
                for (int ai = 0; ai < 2; ++ai)
#pragma unroll
                    for (int m = 0; m < 4; ++m) { f32x4* px = (f32x4*)(X + (size_t)(row0 + ai * HALF + m * 16) * 1024 + co); f32x4 xv = *px; xv = xv + gv * acc[ai][bj][m][n]; *px = xv; } }
    }
};
struct EpiRes192 {
    static constexpr bool PERM = false, AFTER_DRAIN = false;
    float* X; int nh; bf16_t* HB; float* rowss; const PG8_LAS float* tab; mutable int ord;
    __device__ __forceinline__ void operator()(const f32x4 (&acc)[2][2][3][2], const Unit& u, int wr, int wc, int fr, int fq) const {
        const int row0 = u.pm * 192 + wr * 48 + fr, col0 = u.pn * BM + wc * 32 + 8 * fq;
        const PG8_LAS float* tb = tab + ord * 1536 + wc * 32 + 8 * fq; ++ord;
        float ss[2][3];
#pragma unroll
        for (int ai = 0; ai < 2; ++ai)
#pragma unroll
            for (int m = 0; m < 3; ++m) ss[ai][m] = 0.f;
#pragma unroll
        for (int bj = 0; bj < 2; ++bj) {
            f32x4 xin[2][2][3];
#pragma unroll
            for (int n = 0; n < 2; ++n)
#pragma unroll
                for (int ai = 0; ai < 2; ++ai)
#pragma unroll
                    for (int m = 0; m < 3; ++m) xin[n][ai][m] = *(const f32x4*)(X + (size_t)(row0 + ai * 96 + m * 16) * 1024 + col0 + bj * HALF + 4 * n);
#pragma unroll
            for (int n = 0; n < 2; ++n) {
                const int co = col0 + bj * HALF + 4 * n, cl = bj * HALF + 4 * n;
                const f32x4 g0 = *(const PG8_LAS f32x4*)(tb + cl), g1 = *(const PG8_LAS f32x4*)(tb + 256 + cl), g2 = *(const PG8_LAS f32x4*)(tb + 512 + cl);
                const f32x4 w0 = *(const PG8_LAS f32x4*)(tb + 768 + cl), w1 = *(const PG8_LAS f32x4*)(tb + 1024 + cl), w2 = *(const PG8_LAS f32x4*)(tb + 1280 + cl);
#pragma unroll
                for (int ai = 0; ai < 2; ++ai)
#pragma unroll
                    for (int m = 0; m < 3; ++m) { const int row = row0 + ai * 96 + m * 16; const f32x4 gv = row < 4096 ? g0 : (row < 8192 ? g1 : g2);
                        f32x4 xv = xin[n][ai][m]; xv = xv + gv * acc[ai][bj][m][n]; *(f32x4*)(X + (size_t)row * 1024 + co) = xv;
                        if (nh) { const f32x4 wv = row < 4096 ? w0 : (row < 8192 ? w1 : w2); const f32x4 y = xv * wv;
                            ss[ai][m] += (xv[0] * xv[0] + xv[1] * xv[1]) + (xv[2] * xv[2] + xv[3] * xv[3]);
                            u32x2 o; o.x = cvt_pk_bf16(y[0], y[1]); o.y = cvt_pk_bf16(y[2], y[3]); *(u32x2*)(HB + (size_t)row * 1024 + co) = o; } } } }
        if (nh) {
#pragma unroll
            for (int ai = 0; ai < 2; ++ai)
#pragma unroll
                for (int m = 0; m < 3; ++m) { float v = ss[ai][m]; v += __shfl_xor(v, 16); v += __shfl_xor(v, 32);
                    if (fq == 0) rowss[(size_t)(row0 + ai * 96 + m * 16) * 16 + u.pn * 4 + wc] = v; } }
    }
};
struct EpiPool {
    static constexpr bool PERM = false, AFTER_DRAIN = false;
    float* X; const float* xp; const float* xs; int first; const float* gate; const float* pb; const float* ps; const float* nw; const float* sc; bf16_t* HB; float* rowss;
    __device__ __forceinline__ void operator()(const f32x4 (&acc)[2][2][4][2], const Unit& u, int wr, int wc, int fr, int fq) const {
        const int g = u.pn, tile = u.pm - g * 48;
        const int row0 = tile * BM + wr * 64 + fr, col0 = g * BM + wc * 32 + 8 * fq;
        const int cv = tile < 16 ? 0 : (tile < 32 ? 1 : 2);
        const float* xold = first ? (tile < 16 ? xp : xs - (size_t)T_CTX * 1024) : X;
#pragma unroll
        for (int ai = 0; ai < 2; ++ai)
#pragma unroll
            for (int m = 0; m < 4; ++m) { const int row = row0 + ai * HALF + m * 16; float ssv = 0.f;
                f32x4 xin[2][2];
#pragma unroll
                for (int bj = 0; bj < 2; ++bj)
#pragma unroll
                    for (int n = 0; n < 2; ++n) xin[bj][n] = *(const f32x4*)(xold + (size_t)row * 1024 + col0 + bj * HALF + 4 * n);
#pragma unroll
                for (int bj = 0; bj < 2; ++bj)
#pragma unroll
                    for (int n = 0; n < 2; ++n) { const int co = col0 + bj * HALF + 4 * n; const size_t ro = (size_t)row * 1024 + co;
                        const f32x4 gv = *(const f32x4*)(gate + cv * 6144 + co), bv = *(const f32x4*)(pb + co), sv = *(const f32x4*)(ps + co);
                        const f32x4 wv = *(const f32x4*)(nw + co) * (*(const f32x4*)(sc + cv * 6144 + co) + 1.f);
                        f32x4 xv = xin[bj][n]; xv = xv + gv * ((acc[ai][bj][m][n] + bv) * sv); *(f32x4*)(X + ro) = xv;
                        const f32x4 y = xv * wv; ssv += (xv[0] * xv[0] + xv[1] * xv[1]) + (xv[2] * xv[2] + xv[3] * xv[3]);
                        u32x2 o; o.x = cvt_pk_bf16(y[0], y[1]); o.y = cvt_pk_bf16(y[2], y[3]); *(u32x2*)(HB + ro) = o; }
                ssv += __shfl_xor(ssv, 16); ssv += __shfl_xor(ssv, 32);
                if (fq == 0) rowss[(size_t)row * 16 + g * 4 + wc] = ssv; }
    }
};
struct EpiInproj {
    static constexpr bool PERM = false, AFTER_DRAIN = false;
    bf16_t *Q, *K, *V, *Gt; const float* rope; const PG8_LAS float* tab; mutable int ord;
    __device__ __forceinline__ void operator()(const f32x4 (&acc)[2][2][4][2], const Unit& u, int wr, int wc, int fr, int fq) const {
        const int pn = u.pn, row0 = u.pm * BM + wr * 64 + fr;
        const PG8_LAS float* rt = tab + ord * 512 + wr * 64 + fr; const PG8_LAS float* bp = tab + ord * 512 + 256; ++ord;
        float rstd[2][4];
#pragma unroll
        for (int ai = 0; ai < 2; ++ai)
#pragma unroll
            for (int m = 0; m < 4; ++m) rstd[ai][m] = rt[ai * HALF + m * 16];
        if (pn < 8) {
            bf16_t* dst = (pn < 4 ? Q : K) + (pn & 3) * 256;
            const float sc = pn < 4 ? 1.f : 0.0625f;
            const bool lat = u.pm >= 16;
            const int i0 = 16 * wc + 4 * fq;
#pragma unroll
            for (int ai = 0; ai < 2; ++ai)
#pragma unroll
                for (int m = 0; m < 4; ++m) { const int row = row0 + ai * HALF + m * 16; const int t = (row - T_CTX) & 4095;
#pragma unroll
                    for (int bj = 0; bj < 2; ++bj) { const int pos = bj ? (t & 63) : (t >> 6);
                        const f32x4 bb1 = *(const PG8_LAS f32x4*)(bp + bj * HALF + i0), bb2 = *(const PG8_LAS f32x4*)(bp + bj * HALF + 64 + i0);
                        f32x4 x1 = (acc[ai][bj][m][0] * rstd[ai][m] + bb1) * sc, x2 = (acc[ai][bj][m][1] * rstd[ai][m] + bb2) * sc, o1 = x1, o2 = x2;
                        if (lat) { const f32x4 c0 = *(const f32x4*)(rope + (size_t)(pos * 64 + i0) * 2), c1 = *(const f32x4*)(rope + (size_t)(pos * 64 + i0) * 2 + 4);
                            o1[0] = x1[0] * c0[0] - x2[0] * c0[1]; o2[0] = x2[0] * c0[0] + x1[0] * c0[1];
                            o1[1] = x1[1] * c0[2] - x2[1] * c0[3]; o2[1] = x2[1] * c0[2] + x1[1] * c0[3];
                            o1[2] = x1[2] * c1[0] - x2[2] * c1[1]; o2[2] = x2[2] * c1[0] + x1[2] * c1[1];
                            o1[3] = x1[3] * c1[2] - x2[3] * c1[3]; o2[3] = x2[3] * c1[2] + x1[3] * c1[3]; }
                        bf16_t* rp = dst + (size_t)row * 1024 + bj * HALF + i0;
                        u32x2 w1, w2; w1.x = cvt_pk_bf16(o1[0], o1[1]); w1.y = cvt_pk_bf16(o1[2], o1[3]); w2.x = cvt_pk_bf16(o2[0], o2[1]); w2.y = cvt_pk_bf16(o2[2], o2[3]);
                        *(u32x2*)rp = w1; *(u32x2*)(rp + 64) = w2; } }
        } else {
            bf16_t* dst = (pn < 16 ? V + (pn - 8) * 256 : Gt + (pn - 16) * 256) + wc * 32 + 8 * fq;
#pragma unroll
            for (int ai = 0; ai < 2; ++ai)
#pragma unroll
                for (int m = 0; m < 4; ++m) { bf16_t* rowp = dst + (size_t)(row0 + ai * HALF + m * 16) * 2048;
#pragma unroll
                    for (int bj = 0; bj < 2; ++bj) { const f32x4 b0 = *(const PG8_LAS f32x4*)(bp + bj * HALF + wc * 32 + 8 * fq), b1 = *(const PG8_LAS f32x4*)(bp + bj * HALF + wc * 32 + 8 * fq + 4);
                        const f32x4 v0 = acc[ai][bj][m][0] * rstd[ai][m] + b0, v1 = acc[ai][bj][m][1] * rstd[ai][m] + b1;
                        u32x4 w; w.x = cvt_pk_bf16(v0[0], v0[1]); w.y = cvt_pk_bf16(v0[2], v0[3]); w.z = cvt_pk_bf16(v1[0], v1[1]); w.w = cvt_pk_bf16(v1[2], v1[3]);
                        *(u32x4*)(rowp + bj * HALF) = w; } }
        }
    }
};
template <class Epi, class Sched, bool ALIGN_EPI = false, bool SP2 = false, int MF = 4>
__device__ __forceinline__ void gemm_phase(PG8_LAS unsigned char* lds, const Gemm g, const Sched& S, const Epi& E, int tid_in) {
    int tid_ = tid_in; asm volatile("" : "+v"(tid_)); const int tid = tid_, wid = __builtin_amdgcn_readfirstlane(tid >> 6), lane = tid & 63, wr = wid >> 2, wc = wid & 3, fr = lane & 15, fq = lane >> 4;
    const int K = g.K, nt = K / BK;
    unsigned voffA[2], voffB[2];
#pragma unroll
    for (int i = 0; i < 2; ++i) { int R, C; stage_rc(tid * 16 + i * 8192, R, C); const int Rb = Epi::PERM ? ((R & ~31) + perm32(R & 31)) : R;
        voffA[i] = (unsigned)(R * K + C) * 2u; voffB[i] = (unsigned)(Rb * K + C) * 2u; }
    const size_t kstep = (size_t)(BK * 2);
    const size_t hstep = (size_t)HALF * K * 2, hstepA = (size_t)(32 * MF) * K * 2;
    const size_t tstep = 2 * hstep, tstepA = 2 * hstepA;
    const unsigned ldsw = (unsigned)wid * 1024u;
    const int aoff = lds_byte(wr * (16 * MF) + fr, fq * 8), boff = lds_byte(wc * 32 + fr, fq * 8);
#define PG8_SA(b, h) (((b) * 2 + (h)) * HTB)
#define PG8_SB(b, h) ((4 + (b) * 2 + (h)) * HTB)
#define PG8_STAGE(bufoff, gbase, voff) do { _Pragma("unroll") for (int _i = 0; _i < 2; ++_i) \
        __builtin_amdgcn_global_load_lds((const unsigned*)((const char*)(gbase) + (voff)[_i]), (PG8_LAS unsigned*)(lds + (bufoff) + ldsw + _i * 8192), 16, 0, 0); } while (0)
#define PG8_LDA(dst, b, h) do { _Pragma("unroll") for (int m = 0; m < MF; ++m) _Pragma("unroll") for (int k = 0; k < 2; ++k) dst[m][k] = *(const PG8_LAS bf16x8*)(lds + PG8_SA(b, h) + aoff + m * 2048 + k * 1024); } while (0)
#define PG8_LDB(dst, b, h) do { _Pragma("unroll") for (int n = 0; n < 2; ++n) _Pragma("unroll") for (int k = 0; k < 2; ++k) dst[n][k] = *(const PG8_LAS bf16x8*)(lds + PG8_SB(b, h) + boff + n * 2048 + k * 1024); } while (0)
#define PG8_MMA(ai, bj, At, Bt) do { __builtin_amdgcn_s_setprio(1); _Pragma("unroll") for (int m = 0; m < MF; ++m) _Pragma("unroll") for (int n = 0; n < 2; ++n) _Pragma("unroll") for (int k = 0; k < 2; ++k) \
        acc[ai][bj][m][n] = __builtin_amdgcn_mfma_f32_16x16x32_bf16(Bt[n][k], At[m][k], acc[ai][bj][m][n], 0, 0, 0); __builtin_amdgcn_s_setprio(0); } while (0)
#define PG8_WAIT_V(n) asm volatile("s_waitcnt vmcnt(" #n ")" ::: "memory")
#define PG8_WAIT_L(n) asm volatile("s_waitcnt lgkmcnt(" #n ")" ::: "memory")
#define PG8_BAR __builtin_amdgcn_s_barrier()
#define PG8_SCHED __builtin_amdgcn_sched_barrier(0)
    Unit cur, nxt; int ui = 0;
    if (!S.next(0, cur)) return;
    f32x4 acc[2][2][MF][2];
#pragma unroll
    for (int a = 0; a < 2; ++a)
#pragma unroll
        for (int b = 0; b < 2; ++b)
#pragma unroll
            for (int m = 0; m < MF; ++m)
#pragma unroll
                for (int n = 0; n < 2; ++n) acc[a][b][m][n] = (f32x4){0.f, 0.f, 0.f, 0.f};
    bf16x8 At[MF][2], B0[2][2], B1[2][2];
    const char* cA = (const char*)g.A + (size_t)cur.pm * tstepA; const char* cB = (const char*)g.Bt + (size_t)cur.pn * tstep;
    S.a_ready(cur);
    if constexpr (SP2) {
        PG8_STAGE(PG8_SB(0, 0), cB, voffB); PG8_STAGE(PG8_SB(0, 1), cB + hstep, voffB); PG8_STAGE(PG8_SA(0, 0), cA, voffA); PG8_STAGE(PG8_SA(0, 1), cA + hstepA, voffA);
        if (wr == 1) PG8_BAR;
        PG8_WAIT_V(2); PG8_BAR;
        PG8_STAGE(PG8_SB(1, 0), cB + kstep, voffB); PG8_STAGE(PG8_SA(1, 0), cA + kstep, voffA); PG8_STAGE(PG8_SB(1, 1), cB + hstep + kstep, voffB);
        PG8_WAIT_V(6); PG8_BAR;
    } else {
        PG8_STAGE(PG8_SB(0, 0), cB, voffB); PG8_STAGE(PG8_SA(0, 0), cA, voffA); PG8_STAGE(PG8_SB(0, 1), cB + hstep, voffB); PG8_STAGE(PG8_SA(0, 1), cA + hstepA, voffA);
        if (wr == 1) PG8_BAR;
        PG8_WAIT_V(4); PG8_BAR;
        PG8_STAGE(PG8_SB(1, 0), cB + kstep, voffB); PG8_STAGE(PG8_SA(1, 0), cA + kstep, voffA); PG8_STAGE(PG8_SB(1, 1), cB + hstep + kstep, voffB);
        PG8_WAIT_V(6); PG8_BAR;
    }
    for (;;) {
        const bool has_next = S.next(ui + 1, nxt);
        const char* nA = has_next ? (const char*)g.A + (size_t)nxt.pm * tstepA : cA; const char* nB = has_next ? (const char*)g.Bt + (size_t)nxt.pn * tstep : cB;
        for (int t = 0; t < nt; t += 2) {
            const bool last = (t == nt - 2);
            const char* a1 = cA + (size_t)(t + 1) * kstep;
            const char* a2 = last ? nA : cA + (size_t)(t + 2) * kstep; const char* b2 = last ? nB : cB + (size_t)(t + 2) * kstep;
            const char* a3 = a2 + kstep; const char* b3 = b2 + kstep;
            if (last && has_next) S.a_ready(nxt);
            if constexpr (SP2) {
            PG8_LDB(B0, 0, 0); PG8_LDB(B1, 0, 1); PG8_SCHED; PG8_LDA(At, 0, 0); PG8_STAGE(PG8_SA(1, 1), a1 + hstepA, voffA);
            PG8_WAIT_V(8); PG8_WAIT_L(0); PG8_BAR; PG8_MMA(0, 0, At, B0); PG8_MMA(0, 1, At, B1); PG8_BAR; PG8_SCHED;
            PG8_LDA(At, 0, 1); PG8_STAGE(PG8_SB(0, 0), b2, voffB); PG8_STAGE(PG8_SB(0, 1), b2 + hstep, voffB); PG8_STAGE(PG8_SA(0, 0), a2, voffA);
            PG8_WAIT_V(8); PG8_WAIT_L(0); PG8_BAR; PG8_MMA(1, 0, At, B0); PG8_MMA(1, 1, At, B1); PG8_BAR; PG8_SCHED;
            PG8_LDB(B0, 1, 0); PG8_LDB(B1, 1, 1); PG8_SCHED; PG8_LDA(At, 1, 0); PG8_STAGE(PG8_SA(0, 1), a2 + hstepA, voffA);
            PG8_WAIT_V(8); PG8_WAIT_L(0); PG8_BAR; PG8_MMA(0, 0, At, B0); PG8_MMA(0, 1, At, B1); PG8_BAR; PG8_SCHED;
            PG8_LDA(At, 1, 1); PG8_STAGE(PG8_SB(1, 0), b3, voffB); PG8_STAGE(PG8_SB(1, 1), b3 + hstep, voffB); PG8_STAGE(PG8_SA(1, 0), a3, voffA);
            PG8_WAIT_V(8); PG8_WAIT_L(0); PG8_BAR; PG8_MMA(1, 0, At, B0); PG8_MMA(1, 1, At, B1); PG8_BAR; PG8_SCHED;
            } else {
            PG8_LDB(B0, 0, 0); PG8_SCHED; PG8_LDA(At, 0, 0); PG8_STAGE(PG8_SA(1, 1), a1 + hstepA, voffA);
            PG8_WAIT_L(8); PG8_BAR; PG8_WAIT_L(0); PG8_MMA(0, 0, At, B0); PG8_BAR; PG8_SCHED;
            PG8_LDB(B1, 0, 1); PG8_STAGE(PG8_SB(0, 0), b2, voffB);
            PG8_BAR; PG8_WAIT_L(0); PG8_MMA(0, 1, At, B1); PG8_BAR;
            PG8_LDA(At, 0, 1); PG8_STAGE(PG8_SA(0, 0), a2, voffA);
            PG8_BAR; PG8_WAIT_L(0); PG8_MMA(1, 0, At, B0); PG8_BAR; PG8_SCHED;
            PG8_STAGE(PG8_SB(0, 1), b2 + hstep, voffB);
            PG8_WAIT_V(6); PG8_BAR; PG8_MMA(1, 1, At, B1); PG8_BAR;
            PG8_LDB(B0, 1, 0); PG8_SCHED; PG8_LDA(At, 1, 0); PG8_STAGE(PG8_SA(0, 1), a2 + hstepA, voffA);
            PG8_WAIT_L(8); PG8_BAR; PG8_WAIT_L(0); PG8_MMA(0, 0, At, B0); PG8_BAR; PG8_SCHED;
            PG8_LDB(B1, 1, 1); PG8_STAGE(PG8_SB(1, 0), b3, voffB);
            PG8_BAR; PG8_WAIT_L(0); PG8_MMA(0, 1, At, B1); PG8_BAR;
            PG8_LDA(At, 1, 1); PG8_STAGE(PG8_SA(1, 0), a3, voffA);
            PG8_BAR; PG8_WAIT_L(0); PG8_MMA(1, 0, At, B0); PG8_BAR; PG8_SCHED;
            PG8_STAGE(PG8_SB(1, 1), b3 + hstep, voffB);
            PG8_WAIT_V(6); PG8_BAR; PG8_MMA(1, 1, At, B1); PG8_BAR;
            }
        }
        if constexpr (ALIGN_EPI) { if (wr == 0) PG8_BAR; }
        if constexpr (!Epi::AFTER_DRAIN) { E(acc, cur, wr, wc, fr, fq); S.done(cur); }
        if (!has_next) break;
#pragma unroll
        for (int a = 0; a < 2; ++a)
#pragma unroll
            for (int b = 0; b < 2; ++b)
#pragma unroll
                for (int m = 0; m < MF; ++m)
#pragma unroll
                    for (int n = 0; n < 2; ++n) acc[a][b][m][n] = (f32x4){0.f, 0.f, 0.f, 0.f};
        cur = nxt; cA = nA; cB = nB; ++ui;
        if constexpr (ALIGN_EPI) { if (wr == 1) PG8_BAR; }
    }
    PG8_WAIT_V(0);
    if constexpr (!ALIGN_EPI) { if (wr == 0) PG8_BAR; }
    PG8_BAR;
    if constexpr (Epi::AFTER_DRAIN) { E.fused(acc, cur, wr, wc, fr, fq, lds, wid, lane); S.done(cur); }
#undef PG8_SA
#undef PG8_SB
#undef PG8_STAGE
#undef PG8_LDA
#undef PG8_LDB
#undef PG8_MMA
#undef PG8_WAIT_V
#undef PG8_WAIT_L
#undef PG8_BAR
#undef PG8_SCHED
}
}
#define XB_TMO      128
#define XB_XCNT(j)  (256  + 64 * (j))
#define XB_XSUB(j)  (1280 + 64 * (j))
#define XB_XGEN(j)  (2304 + 64 * (j))
#define XB_TOP      3328
#define XB_TOPGEN   3392
#define XCD_BAR_WORDS 3456
#define XB_SPIN_CAP (1u << 18)

__device__ __forceinline__ unsigned xb_ld(unsigned* p)              { return __hip_atomic_load(p, __ATOMIC_RELAXED, __HIP_MEMORY_SCOPE_AGENT); }
__device__ __forceinline__ unsigned xb_add(unsigned* p, unsigned v) { return __hip_atomic_fetch_add(p, v, __ATOMIC_RELAXED, __HIP_MEMORY_SCOPE_AGENT); }
__device__ __forceinline__ unsigned xb_xcc_id() { return (unsigned)__builtin_amdgcn_s_getreg((3 << 11) | 20) & 0xFu; }
#define XB_SPIN(cond, bar) do { unsigned _sp = 0; while (cond) { __builtin_amdgcn_s_sleep(1); \
    if ((++_sp & 255u) == 0u) { if (xb_ld(&(bar)[XB_TMO])) break; if (_sp > XB_SPIN_CAP) { atomicAdd(&(bar)[XB_TMO], 1u); break; } } } } while (0)

struct XcdBarrier {
    int w0;
    unsigned* bar; unsigned x;
    volatile LAS unsigned* st;
};

__device__ __forceinline__ XcdBarrier xcd_barrier_post(unsigned* bar, volatile LAS unsigned* st) {
    XcdBarrier b; b.bar = bar; b.x = xb_xcc_id(); b.st = st;
    if (threadIdx.x == 0) (void)xb_add(&bar[XB_XCNT(b.x)], 1u);
    return b;
}
__device__ __forceinline__ void xcd_barrier_complete(unsigned* bar, unsigned x, unsigned& nloc, unsigned& nx) {
    const unsigned G = gridDim.x * gridDim.y * gridDim.z;
    unsigned sum, cnt, mine, sp = 0u;
    for (;;) {
        sum = 0u; cnt = 0u; mine = 0u;
#pragma unroll
        for (unsigned j = 0; j < 16; ++j) { const unsigned c = xb_ld(&bar[XB_XCNT(j)]); sum += c; cnt += (c > 0u) ? 1u : 0u; mine = (j == x) ? c : mine; }
        if (sum == G) break;
        __builtin_amdgcn_s_sleep(1);
        if ((++sp & 255u) == 0u) { if (xb_ld(&bar[XB_TMO])) break; if (sp > XB_SPIN_CAP) { atomicAdd(&bar[XB_TMO], 1u); break; } }
    }
    nloc = mine > 0u ? mine : 1u; nx = cnt > 0u ? cnt : 1u;
}

__device__ __forceinline__ void xcd_barrier(const XcdBarrier& b) {
    asm volatile("s_waitcnt vmcnt(0)" ::: "memory");
    __syncthreads();
    if (tid_from_wave(b.w0) == 0) {
        unsigned* bar = b.bar;
        __builtin_amdgcn_s_waitcnt(0);
        unsigned nloc = b.st[0], nx = b.st[1];
        if (nloc == 0u) { xcd_barrier_complete(bar, b.x, nloc, nx); b.st[0] = nloc; b.st[1] = nx; }
        const unsigned old = xb_add(&bar[XB_XSUB(b.x)], 1u);
        const unsigned gen = old / nloc;
        if (old + 1u == (gen + 1u) * nloc) {
            __builtin_amdgcn_fence(__ATOMIC_RELEASE, "agent");
            asm volatile("s_waitcnt vmcnt(0)" ::: "memory");
            const unsigned og = xb_add(&bar[XB_TOP], 1u);
            const unsigned tg = og / nx;
            if (og + 1u == (tg + 1u) * nx) xb_add(&bar[XB_TOPGEN], 1u);
            else XB_SPIN(xb_ld(&bar[XB_TOPGEN]) == tg, bar);
            __builtin_amdgcn_fence(__ATOMIC_ACQUIRE, "agent");
            xb_add(&bar[XB_XGEN(b.x)], 1u);
            asm volatile("s_waitcnt vmcnt(0)" ::: "memory");
        } else {
            XB_SPIN(xb_ld(&bar[XB_XGEN(b.x)]) == gen, bar);
            __builtin_amdgcn_fence(__ATOMIC_ACQUIRE, "agent");
            asm volatile("s_waitcnt vmcnt(0)" ::: "memory");
        }
    }
    __syncthreads();
}

struct Ctx { const Params* p; unsigned char* ws; float* out; LAS unsigned char* lds; int tid, lane, wave, gw, ngw, bid, G; };
__device__ __forceinline__ Ctx fresh_ctx(const Params* pp, LAS unsigned char* lds, int wave0);
__device__ __forceinline__ Ctx fresh_ctx(const Params* pp, LAS unsigned char* lds, int wave0) {
    Ctx c; c.p = pp; c.lds = lds;
    int tid = tid_from_wave(wave0); asm volatile("" : "+v"(tid));
    int bid = blockIdx.x; asm volatile("" : "+s"(bid));
    int G = gridDim.x; asm volatile("" : "+s"(G));
    unsigned char* ws = pp->ws; asm volatile("" : "+s"(ws));
    float* out = pp->out; asm volatile("" : "+s"(out));
    c.tid = tid; c.lane = tid & 63; c.wave = __builtin_amdgcn_readfirstlane(tid >> 6); c.bid = bid; c.G = G; c.ws = ws; c.out = out; c.gw = bid * NWAVES + c.wave; c.ngw = G * NWAVES;
    return c;
}
__device__ __forceinline__ const float* inp(const Ctx& c, int i) { asm volatile("" : "+s"(i)); return c.p->in[i]; }

__device__ __forceinline__ void p0_transpose_item(const float* W, int K, int N, bf16_t* WT, LAS float* scr, int item, int lane, int mode, const float* sh = nullptr, float* biasp = nullptr) {
    const int nblk = N / 32, kb = item / nblk, nb = item % nblk, k0 = 64 * kb, n0 = 32 * nb;
#pragma unroll 8
    for (int i = 0; i < 32; ++i) { const int kk = 2 * i + (lane >> 5); scr[kk * 33 + (lane & 31)] = __builtin_nontemporal_load(W + (size_t)(k0 + kk) * N + n0 + (lane & 31)); }
    if (sh) { LAS float* shl = scr + 64 * 33;
#pragma unroll
        for (int cvv = 0; cvv < 3; ++cvv) shl[cvv * 64 + lane] = sh[(size_t)cvv * NMOD + k0 + lane]; }
    asm volatile("s_waitcnt lgkmcnt(0)" ::: "memory");
    if (sh) { const LAS float* shl = scr + 64 * 33; const int n = lane & 31, kh = (lane >> 5) * 32; float a0 = 0.f, a1 = 0.f, a2 = 0.f;
#pragma unroll 8
        for (int kk = 0; kk < 32; ++kk) { const float wv = scr[(kh + kk) * 33 + n]; a0 += shl[kh + kk] * wv; a1 += shl[64 + kh + kk] * wv; a2 += shl[128 + kh + kk] * wv; }
        a0 += __shfl_xor(a0, 32); a1 += __shfl_xor(a1, 32); a2 += __shfl_xor(a2, 32);
        if (lane < 32) { float* o = biasp + (size_t)(kb * 3) * N + n0 + n; o[0] = a0; o[N] = a1; o[2 * (size_t)N] = a2; } }
    const int c = lane & 7;
#pragma unroll
    for (int j = 0; j < 4; ++j) { const int n = (lane >> 3) + 8 * j; const LAS float* s = scr + (8 * c) * 33 + n;
        u32x4 o; o.x = cvt_pk_bf16(s[0 * 33], s[1 * 33]); o.y = cvt_pk_bf16(s[2 * 33], s[3 * 33]); o.z = cvt_pk_bf16(s[4 * 33], s[5 * 33]); o.w = cvt_pk_bf16(s[6 * 33], s[7 * 33]);
        const int L = n0 + n, Pn = (mode == 1 && L < 2048) ? permrope(L) : perm8(L);
        *(u32x4*)(WT + (size_t)Pn * K + k0 + 8 * c) = o; }
    asm volatile("s_waitcnt lgkmcnt(0)" ::: "memory");
}
__device__ __forceinline__ void phase_p0(const Ctx& c) {
    unsigned char* ws = c.ws;
    { LAS float* sl = (LAS float*)c.lds;
      float* modp = (float*)(ws + WS_MODP);
      for (int u = c.bid; u < 768; u += c.G) {
        const int l = u / 192, rem = u % 192, kc = rem / 12, nb = rem % 12, n = nb * 512 + c.tid;
        __syncthreads();
        if (c.tid < 192) { const int cvv = c.tid >> 6, k = 64 * kc + (c.tid & 63); const float v = cvv == 0 ? inp(c, I_CCTX)[k] : inp(c, I_C)[(cvv - 1) * 1024 + k]; sl[c.tid] = silu_f(v); }
        __syncthreads();
        float a0 = 0.f, a1 = 0.f, a2 = 0.f; const float* w = inp(c, I_WADA) + ((size_t)l * 1024 + 64 * kc) * NMOD + n;
#pragma unroll 8
        for (int k = 0; k < 64; ++k) { const float wv = __builtin_nontemporal_load(w + (size_t)k * NMOD); a0 += sl[k] * wv; a1 += sl[64 + k] * wv; a2 += sl[128 + k] * wv; }
        float* o = modp + (size_t)((l * 16 + kc) * 3) * NMOD + n; o[0] = a0; o[NMOD] = a1; o[2 * NMOD] = a2;
      }
      __syncthreads();
    }
    { float* rope = (float*)(ws + WS_TAB + TAB_ROPE); float* pw = (float*)(ws + WS_TAB + TAB_POW);
      const int gt = c.bid * NTHREADS + c.tid, ngt = c.G * NTHREADS;
      for (int i = gt; i < 4096; i += ngt) { const int pos = i >> 6, fi = i & 63; const float fr = powf(10000.f, -(float)fi / 64.f); const float ang = (float)pos * fr; rope[2 * i] = cosf(ang); rope[2 * i + 1] = sinf(ang); }
      for (int i = gt; i < 16 * 132; i += ngt) { const int n = i % 132, q = i / 132; const float lg = log1pf(-exp2f(-inp(c, I_DECAY)[q])); pw[i] = expf(lg * (float)n); }
    }
    { LAS float* scr = (LAS float*)(c.lds + c.wave * 9216);
      constexpr int I2 = 2048, IOUT = 1024, IP = 32;
      constexpr int NIT = 4 * I2 + 2 * IOUT + 8 * IP;
      for (int it = c.gw; it < NIT; it += c.ngw) {
        int r = it;
        if (r < 4 * I2) { const int l = r / I2; p0_transpose_item(inp(c, I_W2) + (size_t)l * 4096 * 1024, 4096, 1024, (bf16_t*)(ws + WS_W2T) + (size_t)l * 1024 * 4096, scr, r % I2, c.lane, 0); continue; } r -= 4 * I2;
        if (r < 2 * IOUT) { const int l = r / IOUT; p0_transpose_item(inp(c, I_WOUT) + (size_t)l * HV * 1024, HV, 1024, (bf16_t*)(ws + WS_WOUTT) + (size_t)l * 1024 * HV, scr, r % IOUT, c.lane, 0); continue; } r -= 2 * IOUT;
        { const int l = r / IP; p0_transpose_item(inp(c, I_PW) + (size_t)l * 65536, 256, 256, (bf16_t*)(ws + WS_PWT) + (size_t)l * 65536, scr, r % IP, c.lane, 0); }
      }
    }
}
__device__ __forceinline__ void phase_p0c(const Ctx& c) {
    unsigned char* ws = c.ws; const float* mod = (const float*)(ws + WS_MOD); float* biasp = (float*)(ws + WS_BIASP);
    LAS float* scr = (LAS float*)(c.lds + c.wave * 9216);
    constexpr int I1 = 2048, IIN = 3072, NIT = 4 * I1 + 2 * IIN;
    for (int it = c.gw; it < NIT; it += c.ngw) {
        int r = it;
        if (r < 4 * I1) { const int l = r / I1; p0_transpose_item(inp(c, I_W1) + (size_t)l * 1024 * 4096, 1024, 4096, (bf16_t*)(ws + WS_W1T) + (size_t)l * 4096 * 1024, scr, r % I1, c.lane, 0,
                                                                   mod + (size_t)(l * 3) * NMOD + 3 * 1024, biasp + (size_t)l * 16 * 3 * 4096); continue; } r -= 4 * I1;
        { const int jr = r / IIN, l = 2 * jr + 1; p0_transpose_item(inp(c, I_WIN) + (size_t)jr * 1024 * RIN, 1024, RIN, (bf16_t*)(ws + WS_WINT) + (size_t)jr * RIN * 1024, scr, r % IIN, c.lane, 1,
                                                                   mod + (size_t)(l * 3) * NMOD, biasp + (size_t)4 * 16 * 3 * 4096 + (size_t)jr * 16 * 3 * RIN); }
    }
}
__device__ __forceinline__ void bias_finalize(const Ctx& c) {
    const float* biasp = (const float*)(c.ws + WS_BIASP); float* bu = (float*)(c.ws + WS_BIASU); float* bi = (float*)(c.ws + WS_BIASI);
    const int gt = c.bid * NTHREADS + c.tid, ngt = c.G * NTHREADS;
    for (int i = gt; i < 4 * 3 * 4096 + 2 * 3 * RIN; i += ngt) {
        const bool up = i < 4 * 3 * 4096; const int q = up ? i : i - 4 * 3 * 4096, N = up ? 4096 : RIN, n = q % N, cvv = (q / N) % 3, l = q / (3 * N);
        const float* src = biasp + (up ? (size_t)l * 16 * 3 * 4096 : (size_t)4 * 16 * 3 * 4096 + (size_t)l * 16 * 3 * RIN) + (size_t)cvv * N + n;
        float s = 0.f;
#pragma unroll
        for (int kb = 0; kb < 16; ++kb) s += src[(size_t)kb * 3 * N];
        (up ? bu : bi)[q] = s; }
}
__device__ __forceinline__ void phase_p0b(const Ctx& c) {
    const float* modp = (const float*)(c.ws + WS_MODP); float* mod = (float*)(c.ws + WS_MOD);
    const int gt = c.bid * NTHREADS + c.tid, ngt = c.G * NTHREADS;
    for (int i = gt; i < 4 * 3 * NMOD; i += ngt) { const int n = i % NMOD, cvv = (i / NMOD) % 3, l = i / (3 * NMOD);
        float s = inp(c, I_BADA)[l * NMOD + n];
#pragma unroll
        for (int kc = 0; kc < 16; ++kc) s += modp[(size_t)((l * 16 + kc) * 3 + cvv) * NMOD + n];
        mod[i] = s; }
}
template <int MODE> __device__ __forceinline__ void phase_norm(const Ctx& c, int l, int which, int from_input) {
    const float* X = (const float*)(c.ws + WS_X); const float* mod = (const float*)(c.ws + WS_MOD);
    const float* nw = MODE == 2 ? inp(c, I_FNW) : (which ? inp(c, I_NMLP) : inp(c, I_NMIX)) + l * 1024;
    for (int row = c.gw; row < T; row += c.ngw) {
        const float* xr = from_input ? (row < T_CTX ? inp(c, I_XP) + (size_t)row * 1024 : inp(c, I_XS) + (size_t)(row - T_CTX) * 1024) : X + (size_t)row * 1024;
        f32x4 v[4]; float ss = 0.f;
#pragma unroll
        for (int j = 0; j < 4; ++j) { v[j] = *(const f32x4*)(xr + 4 * c.lane + 256 * j); ss += (v[j][0] * v[j][0] + v[j][1] * v[j][1]) + (v[j][2] * v[j][2] + v[j][3] * v[j][3]); }
        const float rstd = rsqrtf(wave_sum(ss) * (1.f / 1024.f) + NORM_EPS);
        const float* mrow = mod + (size_t)(l * 3 + cv_of_row(row)) * NMOD + (which ? 3 : 0) * 1024;
#pragma unroll
        for (int j = 0; j < 4; ++j) { const int col = 4 * c.lane + 256 * j; const f32x4 w = *(const f32x4*)(nw + col); f32x4 h = v[j] * rstd * w;
            if (MODE != 2) { const f32x4 sh = *(const f32x4*)(mrow + col), sc = *(const f32x4*)(mrow + 1024 + col); h = h * (sc + 1.f) + sh; }
            if (MODE == 0) { u32x2 o; o.x = cvt_pk_bf16(h[0], h[1]); o.y = cvt_pk_bf16(h[2], h[3]); *(u32x2*)((bf16_t*)(c.ws + WS_HB) + (size_t)row * 1024 + col) = o; }
            else if (MODE == 1) { u32x2 o; o.x = cvt_pk_bf16(h[0], h[1]); o.y = cvt_pk_bf16(h[2], h[3]); *(u32x2*)((bf16_t*)(c.ws + WS_HF32) + (size_t)row * 1024 + col) = o; }
            else __builtin_nontemporal_store(h, (f32x4*)(c.out + (size_t)row * 1024 + col)); }
    }
}
__device__ __forceinline__ void up8(const u32x4 v, f32x4& a, f32x4& b) {
    a = (f32x4){bf2f(v.x & 0xffffu), bf2f(v.x >> 16), bf2f(v.y & 0xffffu), bf2f(v.y >> 16)}; b = (f32x4){bf2f(v.z & 0xffffu), bf2f(v.z >> 16), bf2f(v.w & 0xffffu), bf2f(v.w >> 16)}; }
__device__ __forceinline__ u32x4 pk8(const f32x4 a, const f32x4 b) { u32x4 o; o.x = cvt_pk_bf16(a[0], a[1]); o.y = cvt_pk_bf16(a[2], a[3]); o.z = cvt_pk_bf16(b[0], b[1]); o.w = cvt_pk_bf16(b[2], b[3]); return o; }
__device__ __forceinline__ void slide16b(const bf16_t* src, int base, int stride, int L, int w, int p0, const bf16_t* hsub, u32x4 (&outp)[16]) {
    const int h2 = w >> 1;
    const int lo0 = max(p0 - h2, 0), hi0 = min(p0 - h2 + w, L);
    f32x4 Sa = {0.f, 0.f, 0.f, 0.f}, Sb = {0.f, 0.f, 0.f, 0.f};
#pragma unroll
    for (int k = 0; k < 16; ++k) { const int q = lo0 + k; f32x4 a, b; up8(*(const u32x4*)(src + (size_t)(base + min(q, L - 1) * stride) * 1024), a, b); if (q < hi0) { Sa = Sa + a; Sb = Sb + b; } }
#pragma unroll
    for (int k = 0; k < 16; ++k) { const int p = p0 + k;
        if (k > 0) { const int qa = p - 1 - h2, qb = p - h2 + w - 1; f32x4 a0, b0, a1, b1;
            up8(*(const u32x4*)(src + (size_t)(base + max(qa, 0) * stride) * 1024), a0, b0); up8(*(const u32x4*)(src + (size_t)(base + min(qb, L - 1) * stride) * 1024), a1, b1);
            if (qa >= 0) { Sa = Sa - a0; Sb = Sb - b0; }
            if (qb < L) { Sa = Sa + a1; Sb = Sb + b1; } }
        const int lo = max(p - h2, 0), hi = min(p - h2 + w, L); const float inv = 1.f / (float)(hi - lo);
        f32x4 ma = Sa * inv, mb = Sb * inv;
        if (hsub) { f32x4 ha, hb; up8(*(const u32x4*)(hsub + (size_t)(base + p * stride) * 1024), ha, hb); ma = ma - ha; mb = mb - hb; }
        outp[k] = pk8(ma, mb); }
}
__device__ __forceinline__ void phase_pool_v(const Ctx& c) {
    const bf16_t* hf = (const bf16_t*)(c.ws + WS_HF32); bf16_t* vs = (bf16_t*)(c.ws + WS_VS);
    const int gt = c.bid * NTHREADS + c.tid, ngt = c.G * NTHREADS;
    for (int i = gt; i < 768 * 128; i += ngt) { const int seg = i >> 7, ch = (i & 127) * 8, w = 2 << (ch >> 8);
        int base, stride, L, p0;
        if (seg < 256) { base = (seg >> 4) * 256; stride = 1; L = 256; p0 = (seg & 15) * 16; }
        else { const int s2 = seg - 256, cc = s2 & 63, rs = (s2 >> 6) & 3, b = s2 >> 8; base = T_CTX + b * 4096 + cc; stride = 64; L = 64; p0 = rs * 16; }
        u32x4 o[16];
        slide16b(hf + ch, base, stride, L, w, p0, nullptr, o);
#pragma unroll
        for (int k = 0; k < 16; ++k) *(u32x4*)(vs + (size_t)(base + (p0 + k) * stride) * 1024 + ch) = o[k]; }
}
__device__ __forceinline__ void phase_pool_h(const Ctx& c) {
    const bf16_t* hf = (const bf16_t*)(c.ws + WS_HF32); const bf16_t* vs = (const bf16_t*)(c.ws + WS_VS); bf16_t* db = (bf16_t*)(c.ws + WS_DBUF);
    const int gt = c.bid * NTHREADS + c.tid, ngt = c.G * NTHREADS;
    for (int i = gt; i < 768 * 128; i += ngt) { const int seg = i >> 7, ch = (i & 127) * 8, g = ch >> 8, w = 2 << g;
        const int t0 = seg * 16;
        u32x4 o[16];
        if (seg < 256) {
            u32x4 mv[16], hv[16];
#pragma unroll
            for (int k = 0; k < 16; ++k) { mv[k] = *(const u32x4*)(vs + (size_t)(t0 + k) * 1024 + ch); hv[k] = *(const u32x4*)(hf + (size_t)(t0 + k) * 1024 + ch); }
#pragma unroll
            for (int k = 0; k < 16; ++k) { f32x4 ma, mb, ha, hb; up8(mv[k], ma, mb); up8(hv[k], ha, hb); o[k] = pk8(ma - ha, mb - hb); }
        } else slide16b(vs + ch, t0 & ~63, 1, 64, w, t0 & 63, hf + ch, o);
#pragma unroll
        for (int k = 0; k < 16; ++k) *(u32x4*)(db + ((size_t)g * T + t0 + k) * 256 + (ch & 255)) = o[k]; }
}
__device__ __forceinline__ void phase_tr(const Ctx& c) {
    LAS unsigned char* scr = c.lds + c.wave * 8448;
    const int lane = c.lane;
#define TR_LOAD(dst8, item) do { const int tb_ = (item) % 192, cb_ = (item) / 192; const bf16_t* src_ = cb_ < 16 ? (const bf16_t*)(c.ws + WS_K) + cb_ * 64 : (const bf16_t*)(c.ws + WS_V) + (cb_ - 16) * 64; const int ld_ = cb_ < 16 ? 1024 : 2048; \
    _Pragma("unroll") for (int i = 0; i < 8; ++i) { const int pc = lane + 64 * i; dst8[i] = __builtin_nontemporal_load((const u32x4*)(src_ + (size_t)(tb_ * 64 + (pc >> 3)) * ld_ + (pc & 7) * 8)); } } while (0)
    u32x4 cur[8], nxt[8];
    if (c.gw < 192 * 48) TR_LOAD(cur, c.gw);
    for (int it = c.gw; it < 192 * 48; it += c.ngw) {
        const int tb = it % 192, cb = it / 192;
        bf16_t* dst = cb < 16 ? (bf16_t*)(c.ws + WS_KT) + (size_t)(cb * 64) * T : (bf16_t*)(c.ws + WS_VT) + (size_t)((cb - 16) * 64) * T;
        const int tok0 = tb * 64;
        const bool more = it + c.ngw < 192 * 48;
        if (more) TR_LOAD(nxt, it + c.ngw);
#pragma unroll
        for (int i = 0; i < 8; ++i) { const int pc = lane + 64 * i, r = pc >> 3, ch = pc & 7; const u32x4 v = cur[i];
            LAS unsigned* d = (LAS unsigned*)(scr + r * 132 + ch * 16); d[0] = v.x; d[1] = v.y; d[2] = v.z; d[3] = v.w; }
        asm volatile("s_waitcnt lgkmcnt(0)" ::: "memory");
        const int tg = lane & 7, cl = lane >> 3;
#pragma unroll
        for (int i = 0; i < 8; ++i) { const int col = cl + 8 * i; const LAS bf16_t* s = (const LAS bf16_t*)(scr + (tg * 8) * 132 + col * 2);
            u32x4 o; o.x = (unsigned)s[0] | ((unsigned)s[66] << 16); o.y = (unsigned)s[2 * 66] | ((unsigned)s[3 * 66] << 16); o.z = (unsigned)s[4 * 66] | ((unsigned)s[5 * 66] << 16); o.w = (unsigned)s[6 * 66] | ((unsigned)s[7 * 66] << 16);
            if (cb < 16) { const int dd = (cb & 3) * 64 + col, j0 = (tok0 & 127) + 8 * tg;
                const int frag = (((((tok0 >> 7) * 4 + (cb >> 2)) * 8 + (dd >> 5)) * 2 + ((dd >> 2) & 1)) * 4 + (j0 >> 5)) * 64 + ((j0 >> 3) & 3) * 16 + ((((dd >> 3) & 3) << 2) | (dd & 3));
                *(u32x4*)((bf16_t*)(c.ws + WS_KT) + (size_t)frag * 8) = o; }
            else *(u32x4*)(dst + (size_t)col * T + tok0 + tg * 8) = o; }
        asm volatile("s_waitcnt lgkmcnt(0)" ::: "memory");
        if (more) {
#pragma unroll
            for (int i = 0; i < 8; ++i) cur[i] = nxt[i]; }
    }
#undef TR_LOAD
}
#define MFMA16(a, b, c) __builtin_amdgcn_mfma_f32_16x16x32_bf16((a), (b), (c), 0, 0, 0)
__device__ __forceinline__ size_t sbuf_index(int slot, int h, int dir) {
    return slot >= 32 ? (size_t)(((slot - 32) * 4 + h) * 2 + dir) : (size_t)(512 + (((slot >> 1) * 4 + h) * 2 + dir));
}
#define R1_LOADA(dst, chunk_tok0) do { _Pragma("unroll") for (int md_ = 0; md_ < 2; ++md_) _Pragma("unroll") for (int ks_ = 0; ks_ < 4; ++ks_) \
    dst[md_][ks_] = *(const bf16x8*)(KTg + ((size_t)((((((chunk_tok0) >> 7) * 4 + h) * 8 + w) * 2 + md_) * 4 + ks_) * 64 + lane) * 8); } while (0)
#define R1_LOADV(dst, chunk_tok0) do { _Pragma("unroll") for (int i_ = 0; i_ < 2; ++i_) { const int pc_ = tid + 512 * i_; \
    dst[i_] = *(const u32x4*)(VTg + (size_t)(h * 512 + 64 * es + (pc_ >> 4)) * T + (chunk_tok0) + (pc_ & 15) * 8); } } while (0)
#define R1_WRITEV(src, buf) do { _Pragma("unroll") for (int i_ = 0; i_ < 2; ++i_) { const int pc_ = tid + 512 * i_, r_ = pc_ >> 4, cj_ = pc_ & 15; const u32x4 v_ = src[i_]; \
    const LAS float* z_ = zl + (dir ? cj_ * 8 : 127 - cj_ * 8); const int zs_ = dir ? 1 : -1; u32x4 o_; \
    o_.x = cvt_pk_bf16(bf2f(v_.x & 0xffffu) * z_[0], bf2f(v_.x >> 16) * z_[zs_]); o_.y = cvt_pk_bf16(bf2f(v_.y & 0xffffu) * z_[2 * zs_], bf2f(v_.y >> 16) * z_[3 * zs_]); \
    o_.z = cvt_pk_bf16(bf2f(v_.z & 0xffffu) * z_[4 * zs_], bf2f(v_.z >> 16) * z_[5 * zs_]); o_.w = cvt_pk_bf16(bf2f(v_.w & 0xffffu) * z_[6 * zs_], bf2f(v_.w >> 16) * z_[7 * zs_]); \
    *(LAS u32x4*)(vT + (buf) * 17408 + r_ * 272 + cj_ * 16) = o_; } } while (0)
#ifndef R1_STORE_REP
#define R1_STORE_REP 1
#endif
#define R1_STEP(ci_, Acur) do { const int ci = (ci_); const int ch = dir ? nch - 1 - ci : ci, slot = slot_base + ch; \
    __syncthreads(); \
    if (lat || ci == 1) { bf16_t* so = sb + sbuf_index(slot, h, dir) * 131072; \
        _Pragma("unroll") for (int ne = 0; ne < 4; ++ne) { u32x4 o; o.x = cvt_pk_bf16(acc[0][ne][0], acc[0][ne][1]); o.y = cvt_pk_bf16(acc[0][ne][2], acc[0][ne][3]); o.z = cvt_pk_bf16(acc[1][ne][0], acc[1][ne][1]); o.w = cvt_pk_bf16(acc[1][ne][2], acc[1][ne][3]); \
            __builtin_nontemporal_store(o, (u32x4*)(so + ((size_t)((es * 8 + w) * 4 + ne) * 64 + lane) * 8)); } } \
    if (ci + 1 < nch) R1_WRITEV(vraw, (ci + 1) & 1); \
    if (ci + 2 < nch) { const int ch2 = dir ? nch - 3 - ci : ci + 2; R1_LOADV(vraw, tok_base + ch2 * 128); } \
    _Pragma("unroll") for (int md = 0; md < 2; ++md) _Pragma("unroll") for (int ne = 0; ne < 4; ++ne) acc[md][ne] = acc[md][ne] * gC; \
    _Pragma("unroll") for (int ks = 0; ks < 4; ++ks) { bf16x8 b[4]; \
        _Pragma("unroll") for (int ne = 0; ne < 4; ++ne) b[ne] = *(const LAS bf16x8*)(vT + (ci & 1) * 17408 + (16 * ne + fr) * 272 + ks * 64 + fq * 16); \
        _Pragma("unroll") for (int md = 0; md < 2; ++md) _Pragma("unroll") for (int ne = 0; ne < 4; ++ne) acc[md][ne] = MFMA16(Acur[md][ks], b[ne], acc[md][ne]); } \
    if (ci + 2 < nch) { const int ch2 = dir ? nch - 3 - ci : ci + 2; R1_LOADA(Acur, tok_base + ch2 * 128); } } while (0)
__device__ __forceinline__ void phase_r1(const Ctx& c, int jr) {
    LAS unsigned char* vT = c.lds;
    LAS float* zl = (LAS float*)(c.lds + 2 * 17408);
    const bf16_t* KTg = (const bf16_t*)(c.ws + WS_KT); const bf16_t* VTg = (const bf16_t*)(c.ws + WS_VT);
    bf16_t* sb = (bf16_t*)(c.ws + WS_SBUF); const float* pwt = (const float*)(c.ws + WS_TAB + TAB_POW);
    const int tid = c.tid, w = c.wave, lane = c.lane, fr = lane & 15, fq = lane >> 4;
    const int nb = c.G, half = nb / 2; const bool lat = c.bid < half;
    const int ntask = lat ? 128 : 1024;
#ifndef R1_CTX_BLOCKS
#define R1_CTX_BLOCKS (nb - half)
#endif
    int bb = lat ? c.bid : c.bid - half; const int nbl = lat ? half : R1_CTX_BLOCKS;
    for (int tq = (lat || bb < nbl) ? bb : ntask; tq < ntask; tq += nbl) {
        int tk = tq;
        if (nbl == 128) { const int x = bb & 7, r = bb >> 3; tk = lat ? ((x * 2 + (r >> 3)) * 8 + (r & 7)) : (((r * 8 + x) * 8) + (tq >> 7)); }
        const int es = tk & 7, dir = (tk >> 3) & 1, h = (tk >> 4) & 3, s = tk >> 6;
        const int nch = lat ? 32 : 2, tok_base = lat ? T_CTX + s * 4096 : s * 256, slot_base = lat ? 32 + s * 32 : s * 2;
        const float* pw = pwt + ((jr * 2 + dir) * 4 + h) * 132; const float gC = pw[128];
        f32x4 acc[2][4];
#pragma unroll
        for (int md = 0; md < 2; ++md)
#pragma unroll
            for (int ne = 0; ne < 4; ++ne) {
                if (lat) { const float* sp = inp(c, I_STATE) + ((size_t)(((s * 2 + jr) * 2 + dir) * 4 + h) * 256 + 32 * w + 8 * fq + 4 * md) * 512 + 64 * es + 16 * ne + fr;
                    acc[md][ne] = (f32x4){sp[0], sp[512], sp[1024], sp[1536]}; }
                else acc[md][ne] = (f32x4){0.f, 0.f, 0.f, 0.f}; }
        bf16x8 A0[2][4], A1[2][4]; u32x4 vraw[2];
        { const int c0 = dir ? nch - 1 : 0, c1 = dir ? nch - 2 : 1;
          __syncthreads();
          if (tid < 132) zl[tid] = pw[tid];
          R1_LOADV(vraw, tok_base + c0 * 128); R1_LOADA(A0, tok_base + c0 * 128);
          __syncthreads();
          R1_WRITEV(vraw, 0);
          R1_LOADV(vraw, tok_base + c1 * 128); R1_LOADA(A1, tok_base + c1 * 128); }
        for (int ci2 = 0; ci2 < nch; ci2 += 2) { R1_STEP(ci2, A0); R1_STEP(ci2 + 1, A1); }
        if (!lat) { float* op = c.out + (size_t)T * 1024 + ((size_t)(((s * 2 + jr) * 2 + dir) * 4 + h) * 256 + 32 * w + 8 * fq) * 512 + 64 * es + fr;
#pragma unroll
            for (int md = 0; md < 2; ++md)
#pragma unroll
                for (int ne = 0; ne < 4; ++ne)
#pragma unroll
                    for (int r = 0; r < 4; ++r) __builtin_nontemporal_store(acc[md][ne][r], op + (size_t)(4 * md + r) * 512 + 16 * ne); }
    }
}
__device__ __forceinline__ void phase_r2(const Ctx& c, int jr) {
    LAS unsigned char* lds = c.lds;
    LAS unsigned char* Pm = lds;
    LAS unsigned char* Ab = lds + 34816;
    LAS unsigned char* Bb = lds + 34816 + 2 * 18432;
    LAS float* pwl = (LAS float*)(lds + 34816 + 2 * 18432 + 2 * 36864);
    const bf16_t* Qg = (const bf16_t*)(c.ws + WS_Q); const bf16_t* Kg = (const bf16_t*)(c.ws + WS_K); const bf16_t* VTg = (const bf16_t*)(c.ws + WS_VT);
    const bf16_t* sb = (const bf16_t*)(c.ws + WS_SBUF); const float* pwt = (const float*)(c.ws + WS_TAB + TAB_POW); bf16_t* Og = (bf16_t*)(c.ws + WS_O);
    const int tid = c.tid, w = c.wave, lane = c.lane, fr = lane & 15, fq = lane >> 4, wi = w >> 2, wj = w & 3;
    for (int task0 = c.bid; task0 < 768; task0 += c.G) {
        int task = task0;
        if (c.G == 256) task = ((((task0 >> 8) * 128) + ((c.bid >> 4) << 3 | (c.bid & 7))) << 1) | ((c.bid >> 3) & 1);
        const int eh = task & 1, h = (task >> 1) & 3, slot = task >> 3, tok0 = slot * 128;
        const bool lat = slot >= 32; const bool has_f = lat || (slot & 1) == 1, has_b = lat || (slot & 1) == 0;
        const bf16_t* qrow = Qg + (size_t)tok0 * 1024 + h * 256; const bf16_t* krow = Kg + (size_t)tok0 * 1024 + h * 256;
        const bf16_t* vrow = VTg + (size_t)(h * 512 + eh * 256) * T + tok0;
        const bf16_t* sgf = sb + sbuf_index(slot, h, 0) * 131072; const bf16_t* sgb = sb + sbuf_index(slot, h, 1) * 131072;
        u32x4 RA[6], RB[6];
        const int r16 = tid >> 3, c16 = tid & 7, l16 = r16 * 144 + c16 * 16;
        const int ln = tid & 63, wq = tid >> 6;
        const int soff = ((((4 * eh + (wq >> 3)) * 8 + (wq & 1)) * 4 + ((wq >> 1) & 3)) * 64 + ln) * 8;
        const int NT = 6 + (has_f ? 4 : 0) + (has_b ? 4 : 0);
#define R2_TILE(n) ((n) < 6 ? (n) : (has_f ? (n) : (n) + 4))
#define R2_LOAD_P(t_, R) do { _Pragma("unroll") for (int i = 0; i < 2; ++i) { R[i] = *(const u32x4*)(qrow + (size_t)(r16 + 64 * i) * 1024 + (t_) * 64 + c16 * 8); R[2 + i] = *(const u32x4*)(krow + (size_t)(r16 + 64 * i) * 1024 + (t_) * 64 + c16 * 8); } } while (0)
#define R2_LOAD_V(t_, R) do { _Pragma("unroll") for (int i = 0; i < 4; ++i) R[i] = *(const u32x4*)(vrow + (size_t)(r16 + 64 * i) * T + ((t_) - 4) * 64 + c16 * 8); } while (0)
#define R2_LOAD_S(tile, R) do { const int t_ = (tile); const int kd = (t_ - 6) & 3; const bf16_t* sg = (t_ >= 10 ? sgb : sgf) + soff + (size_t)kd * 4096; \
        _Pragma("unroll") for (int i = 0; i < 4; ++i) R[i] = *(const u32x4*)(sg + (size_t)i * 16384); \
        _Pragma("unroll") for (int i = 0; i < 2; ++i) R[4 + i] = *(const u32x4*)(qrow + (size_t)(r16 + 64 * i) * 1024 + kd * 64 + c16 * 8); } while (0)
#define R2_WRITE_P(R, buf) do { LAS unsigned char* A_ = Ab + (buf) * 18432; LAS unsigned char* B_ = Bb + (buf) * 36864; \
        _Pragma("unroll") for (int i = 0; i < 2; ++i) { *(LAS u32x4*)(A_ + l16 + i * 64 * 144) = R[i]; *(LAS u32x4*)(B_ + l16 + i * 64 * 144) = R[2 + i]; } } while (0)
#define R2_WRITE_V(R, buf) do { LAS unsigned char* B_ = Bb + (buf) * 36864; _Pragma("unroll") for (int i = 0; i < 4; ++i) *(LAS u32x4*)(B_ + l16 + i * 64 * 144) = R[i]; } while (0)
#define R2_WRITE_S(tile, R, buf) do { const int t_ = (tile); LAS unsigned char* A_ = Ab + (buf) * 18432; LAS unsigned char* B_ = Bb + (buf) * 36864; \
        _Pragma("unroll") for (int i = 0; i < 4; ++i) *(LAS u32x4*)(B_ + (wq + 8 * i) * 1024 + ln * 16) = R[i]; \
        _Pragma("unroll") for (int i = 0; i < 2; ++i) { const u32x4 v = R[4 + i]; \
            const float xi = t_ >= 10 ? pwl[132 + 128 - (r16 + 64 * i)] : pwl[r16 + 64 * i + 1]; u32x4 o; \
            o.x = cvt_pk_bf16(bf2f(v.x & 0xffffu) * xi, bf2f(v.x >> 16) * xi); o.y = cvt_pk_bf16(bf2f(v.y & 0xffffu) * xi, bf2f(v.y >> 16) * xi); \
            o.z = cvt_pk_bf16(bf2f(v.z & 0xffffu) * xi, bf2f(v.z >> 16) * xi); o.w = cvt_pk_bf16(bf2f(v.w & 0xffffu) * xi, bf2f(v.w >> 16) * xi); \
            *(LAS u32x4*)(A_ + l16 + i * 64 * 144) = o; } } while (0)
#define R2_MMA_P(cur) do { LAS unsigned char* A_ = Ab + (cur) * 18432; LAS unsigned char* B_ = Bb + (cur) * 36864; \
    _Pragma("unroll") for (int kk = 0; kk < 2; ++kk) { bf16x8 a[2], b[4]; \
        _Pragma("unroll") for (int mj = 0; mj < 2; ++mj) a[mj] = *(const LAS bf16x8*)(B_ + (32 * wj + 16 * mj + fr) * 144 + kk * 64 + fq * 16); \
        _Pragma("unroll") for (int ni = 0; ni < 4; ++ni) b[ni] = *(const LAS bf16x8*)(A_ + (64 * wi + 16 * ni + fr) * 144 + kk * 64 + fq * 16); \
        _Pragma("unroll") for (int mj = 0; mj < 2; ++mj) _Pragma("unroll") for (int ni = 0; ni < 4; ++ni) pacc[mj][ni] = MFMA16(a[mj], b[ni], pacc[mj][ni]); } } while (0)
#define R2_MMA_OS(cur, bptr, bstride) do { LAS unsigned char* B_ = Bb + (cur) * 36864; \
    _Pragma("unroll") for (int kk = 0; kk < 2; ++kk) { bf16x8 b[4]; \
        _Pragma("unroll") for (int ni = 0; ni < 4; ++ni) b[ni] = *(const LAS bf16x8*)((bptr) + (64 * wi + 16 * ni + fr) * (bstride) + kk * 64 + fq * 16); \
        _Pragma("unroll") for (int me = 0; me < 4; me += 2) { const bf16x8 a0 = *(const LAS bf16x8*)(B_ + ((4 * wj + me) * 2 + kk) * 1024 + lane * 16), a1 = *(const LAS bf16x8*)(B_ + ((4 * wj + me + 1) * 2 + kk) * 1024 + lane * 16); \
            _Pragma("unroll") for (int ni = 0; ni < 4; ++ni) oacc[me][ni] = MFMA16(a0, b[ni], oacc[me][ni]); \
            _Pragma("unroll") for (int ni = 0; ni < 4; ++ni) oacc[me + 1][ni] = MFMA16(a1, b[ni], oacc[me + 1][ni]); } } } while (0)
#define R2_MMA_O(cur, bptr, bstride) do { LAS unsigned char* B_ = Bb + (cur) * 36864; \
    _Pragma("unroll") for (int kk = 0; kk < 2; ++kk) { bf16x8 b[4]; \
        _Pragma("unroll") for (int ni = 0; ni < 4; ++ni) b[ni] = *(const LAS bf16x8*)((bptr) + (64 * wi + 16 * ni + fr) * (bstride) + kk * 64 + fq * 16); \
        _Pragma("unroll") for (int me = 0; me < 4; me += 2) { const bf16x8 a0 = *(const LAS bf16x8*)(B_ + (64 * wj + 16 * me + fr) * 144 + kk * 64 + fq * 16), a1 = *(const LAS bf16x8*)(B_ + (64 * wj + 16 * me + 16 + fr) * 144 + kk * 64 + fq * 16); \
            _Pragma("unroll") for (int ni = 0; ni < 4; ++ni) oacc[me][ni] = MFMA16(a0, b[ni], oacc[me][ni]); \
            _Pragma("unroll") for (int ni = 0; ni < 4; ++ni) oacc[me + 1][ni] = MFMA16(a1, b[ni], oacc[me + 1][ni]); } } } while (0)
        __syncthreads();
        { int t2 = tid; asm volatile("" : "+v"(t2));
          if (t2 < 264) { const int dd = t2 >= 132 ? 1 : 0, n = t2 - dd * 132; pwl[t2] = pwt[((jr * 2 + dd) * 4 + h) * 132 + n]; } }
        R2_LOAD_P(0, RA); R2_LOAD_P(1, RB); R2_WRITE_P(RA, 0); R2_LOAD_P(2, RA);
        __syncthreads();
        {
            f32x4 pacc[2][4];
#pragma unroll
            for (int a = 0; a < 2; ++a)
#pragma unroll
                for (int b = 0; b < 4; ++b) pacc[a][b] = (f32x4){0.f, 0.f, 0.f, 0.f};
            R2_WRITE_P(RB, 1); R2_LOAD_P(3, RB); R2_MMA_P(0); __syncthreads();
            R2_WRITE_P(RA, 0); R2_LOAD_V(4, RA); R2_MMA_P(1); __syncthreads();
            R2_WRITE_P(RB, 1); R2_LOAD_V(5, RB); R2_MMA_P(0); __syncthreads();
            R2_WRITE_V(RA, 0); if (NT > 6) R2_LOAD_S(R2_TILE(6), RA); R2_MMA_P(1);
#pragma unroll
            for (int mj = 0; mj < 2; ++mj)
#pragma unroll
                for (int ni = 0; ni < 4; ++ni) { const int i = 64 * wi + 16 * ni + fr, j0 = 32 * wj + 16 * mj + 4 * fq; float v[4];
#pragma unroll
                    for (int r = 0; r < 4; ++r) { const int df = i - (j0 + r); v[r] = pacc[mj][ni][r] * (df >= 0 ? pwl[df] : pwl[132 - df]); }
                    u32x2 o; o.x = cvt_pk_bf16(v[0], v[1]); o.y = cvt_pk_bf16(v[2], v[3]);
                    *(LAS u32x2*)(Pm + i * 272 + j0 * 2) = o; }
            __syncthreads();
        }
        f32x4 oacc[4][4];
#pragma unroll
        for (int a = 0; a < 4; ++a)
#pragma unroll
            for (int b = 0; b < 4; ++b) oacc[a][b] = (f32x4){0.f, 0.f, 0.f, 0.f};
        R2_WRITE_V(RB, 1); if (NT > 7) R2_LOAD_S(R2_TILE(7), RB); R2_MMA_O(0, Pm, 272); __syncthreads();
        if (NT > 6) R2_WRITE_S(R2_TILE(6), RA, 0); if (NT > 8) R2_LOAD_S(R2_TILE(8), RA); R2_MMA_O(1, Pm + 128, 272); __syncthreads();
        for (int n = 6; n < NT; n += 2) {
            if (n + 1 < NT) R2_WRITE_S(R2_TILE(n + 1), RB, 1); if (n + 3 < NT) R2_LOAD_S(R2_TILE(n + 3), RB); R2_MMA_OS(0, Ab, 144); __syncthreads();
            if (n + 2 < NT) R2_WRITE_S(R2_TILE(n + 2), RA, 0); if (n + 4 < NT) R2_LOAD_S(R2_TILE(n + 4), RA); R2_MMA_OS(1, Ab + 18432, 144); __syncthreads();
        }
        {
            int t3 = tid; asm volatile("" : "+v"(t3));
            LAS float* st = (LAS float*)Pm;
            LAS float* st2 = (LAS float*)(Pm + 4096);
            unsigned long long* gstats = (unsigned long long*)(c.ws + WS_MODP); unsigned* gflag = (unsigned*)(c.ws + WS_BAR + 16384);
            const unsigned epoch = (unsigned)jr + 1u;
#pragma unroll
            for (int ni = 0; ni < 4; ++ni) { float s1 = 0.f, s2 = 0.f;
#pragma unroll
                for (int me = 0; me < 4; ++me)
#pragma unroll
                    for (int r = 0; r < 4; ++r) { const float v = oacc[me][ni][r]; s1 += v; s2 += v * v; }
                s1 += __shfl_xor(s1, 16); s1 += __shfl_xor(s1, 32); s2 += __shfl_xor(s2, 16); s2 += __shfl_xor(s2, 32);
                if (fq == 0) { const int i = 64 * wi + 16 * ni + fr; st[(i * 4 + wj) * 2] = s1; st[(i * 4 + wj) * 2 + 1] = s2; } }
            __syncthreads();
            u32x2 gq[4][4]; f32x4 gnv[4];
            const bf16_t* Gg = (const bf16_t*)(c.ws + WS_G); const float* gnw = inp(c, I_GNW) + (jr * 4 + h) * 512 + eh * 256 + 64 * wj + 4 * fq;
#pragma unroll
            for (int me = 0; me < 4; ++me) { gnv[me] = *(const f32x4*)(gnw + 16 * me);
#pragma unroll
                for (int ni = 0; ni < 4; ++ni) gq[me][ni] = *(const u32x2*)(Gg + (size_t)(tok0 + 64 * wi + 16 * ni + fr) * 2048 + h * 512 + eh * 256 + 64 * wj + 16 * me + 4 * fq); }
            float p1 = 0.f, p2 = 0.f;
            if (t3 < 128) {
#pragma unroll
                for (int q = 0; q < 4; ++q) { p1 += st[(t3 * 4 + q) * 2]; p2 += st[(t3 * 4 + q) * 2 + 1]; }
                const unsigned long long pk = (unsigned long long)__builtin_bit_cast(unsigned, p1) | ((unsigned long long)__builtin_bit_cast(unsigned, p2) << 32);
                __hip_atomic_store(gstats + (size_t)task * 128 + t3, pk, __ATOMIC_RELAXED, __HIP_MEMORY_SCOPE_AGENT); }
            asm volatile("s_waitcnt vmcnt(0)" ::: "memory");
            __syncthreads();
            if (t3 == 0) {
                __hip_atomic_store(gflag + task, epoch, __ATOMIC_RELAXED, __HIP_MEMORY_SCOPE_AGENT);
                unsigned sp = 0;
                while (__hip_atomic_load(gflag + (task ^ 1), __ATOMIC_RELAXED, __HIP_MEMORY_SCOPE_AGENT) != epoch) { __builtin_amdgcn_s_sleep(2); if (++sp > (1u << 20)) break; }
                __builtin_amdgcn_fence(__ATOMIC_ACQUIRE, "agent");
                asm volatile("s_waitcnt vmcnt(0)" ::: "memory"); }
            __syncthreads();
            if (t3 < 128) {
                const unsigned long long q = __hip_atomic_load(gstats + (size_t)(task ^ 1) * 128 + t3, __ATOMIC_RELAXED, __HIP_MEMORY_SCOPE_AGENT);
                const float S1 = p1 + __builtin_bit_cast(float, (unsigned)(q & 0xffffffffull)), S2 = p2 + __builtin_bit_cast(float, (unsigned)(q >> 32));
                const float mu = S1 * (1.f / 512.f), var = fmaxf(S2 * (1.f / 512.f) - mu * mu, 0.f);
                st2[t3 * 2] = mu; st2[t3 * 2 + 1] = rsqrtf(var + GN_EPS); }
            __syncthreads();
            bf16_t* Ag = (bf16_t*)(c.ws + WS_A);
#pragma unroll
            for (int ni = 0; ni < 4; ++ni) { const int i = 64 * wi + 16 * ni + fr; const float mu = st2[i * 2], rs = st2[i * 2 + 1];
#pragma unroll
                for (int me = 0; me < 4; ++me) { const u32x2 gb = gq[me][ni];
                    const float g0 = bf2f(gb.x & 0xffffu), g1 = bf2f(gb.x >> 16), g2 = bf2f(gb.y & 0xffffu), g3 = bf2f(gb.y >> 16);
                    const f32x4 o = (oacc[me][ni] - mu) * rs * gnv[me];
                    u32x2 w; w.x = cvt_pk_bf16(silu_f(g0) * o[0], silu_f(g1) * o[1]); w.y = cvt_pk_bf16(silu_f(g2) * o[2], silu_f(g3) * o[3]);
                    *(u32x2*)(Ag + (size_t)(tok0 + i) * 2048 + h * 512 + eh * 256 + 64 * wj + 16 * me + 4 * fq) = w; } }
        }
    }
}
__device__ __forceinline__ void phase_gate(const Ctx& c, int jr) {
    const bf16_t* Og = (const bf16_t*)(c.ws + WS_O); const bf16_t* Gg = (const bf16_t*)(c.ws + WS_G); bf16_t* Ag = (bf16_t*)(c.ws + WS_A);
    const float* gnw = inp(c, I_GNW) + jr * 4 * 512;
    for (int it0 = c.gw; it0 < T * 4; it0 += 4 * c.ngw) {
        u32x2 ob[4][2], gb[4][2];
#pragma unroll
        for (int k = 0; k < 4; ++k) { const int it = min(it0 + k * c.ngw, T * 4 - 1); const size_t base = (size_t)(it >> 2) * 2048 + (it & 3) * 512;
#pragma unroll
            for (int j = 0; j < 2; ++j) { ob[k][j] = *(const u32x2*)(Og + base + 4 * c.lane + 256 * j); gb[k][j] = *(const u32x2*)(Gg + base + 4 * c.lane + 256 * j); } }
#pragma unroll
        for (int k = 0; k < 4; ++k) { const int it = it0 + k * c.ngw; if (it < T * 4) { const int h = it & 3; const size_t base = (size_t)(it >> 2) * 2048 + h * 512;
            f32x4 v[2]; float s = 0.f;
#pragma unroll
            for (int j = 0; j < 2; ++j) { v[j] = (f32x4){bf2f(ob[k][j].x & 0xffffu), bf2f(ob[k][j].x >> 16), bf2f(ob[k][j].y & 0xffffu), bf2f(ob[k][j].y >> 16)}; s += (v[j][0] + v[j][1]) + (v[j][2] + v[j][3]); }
            const float mu = wave_sum(s) * (1.f / 512.f); float q = 0.f;
#pragma unroll
            for (int j = 0; j < 2; ++j) { v[j] = v[j] - mu; q += (v[j][0] * v[j][0] + v[j][1] * v[j][1]) + (v[j][2] * v[j][2] + v[j][3] * v[j][3]); }
            const float rstd = rsqrtf(wave_sum(q) * (1.f / 512.f) + GN_EPS);
#pragma unroll
            for (int j = 0; j < 2; ++j) { const int col = 4 * c.lane + 256 * j; const f32x4 gw = *(const f32x4*)(gnw + h * 512 + col);
                const float g0 = bf2f(gb[k][j].x & 0xffffu), g1 = bf2f(gb[k][j].x >> 16), g2 = bf2f(gb[k][j].y & 0xffffu), g3 = bf2f(gb[k][j].y >> 16);
                const f32x4 o = v[j] * rstd * gw;
                u32x2 w; w.x = cvt_pk_bf16(silu_f(g0) * o[0], silu_f(g1) * o[1]); w.y = cvt_pk_bf16(silu_f(g2) * o[2], silu_f(g3) * o[3]);
                *(u32x2*)(Ag + base + col) = w; } } }
    }
}

#ifndef MULTI_LAUNCH
#define MULTI_LAUNCH 0
#endif
#define PH_ON (ph >= p.ph_lo && ph < p.ph_hi)
#define FRESH const Ctx c = fresh_ctx(&p, lds, bar.w0); unsigned char* const ws = c.ws; const int G = c.G; const float* const mod = (const float*)(ws + WS_MOD); (void)G; (void)mod
#ifndef SYNC_REP
#define SYNC_REP 1
#endif
#ifndef REP_R1
#define REP_R1 1
#endif
#ifndef REP_R2
#define REP_R2 1
#endif
#ifndef REP_LIGHT
#define REP_LIGHT 1
#endif
#ifndef REP_POOL
#define REP_POOL 1
#endif
#ifndef REP_NORM
#define REP_NORM 1
#endif
#ifndef REP_TR
#define REP_TR 1
#endif
#ifndef REP_GATE
#define REP_GATE 1
#endif
#ifndef REP_P0
#define REP_P0 1
#endif
#ifndef REP_P0C
#define REP_P0C 1
#endif
#ifndef REP_GEMM_IN
#define REP_GEMM_IN 1
#endif
#ifndef REP_GEMM_UP
#define REP_GEMM_UP 1
#endif
#ifndef REP_GEMM_DOWN
#define REP_GEMM_DOWN 1
#endif
#ifndef REP_GEMM
#define REP_GEMM 1
#endif
#define PH_END do { ++ph; if (ph > p.ph_lo && ph < p.ph_hi) { for (int r_ = 0; r_ < SYNC_REP; ++r_) xcd_barrier(bar); } } while (0)
template <class Sched> __device__ __forceinline__ void stage_rstd_bias(const Ctx& c, const Sched& S, const float* rowss, const float* bias, int ldb) {
    LAS float* tab = (LAS float*)(c.lds + 132 * 1024);
    pg8::Unit u;
    for (int i = 0; i < 8 && S.next(i, u); ++i) {
        if (c.tid < 256) { const f32x4* rp = (const f32x4*)(rowss + (size_t)(u.pm * 256 + c.tid) * 16); const f32x4 a = rp[0] + rp[1] + rp[2] + rp[3];
            tab[i * 512 + c.tid] = rsqrtf(((a[0] + a[1]) + (a[2] + a[3])) * (1.f / 1024.f) + NORM_EPS); }
        else { const int cvv = u.pm < 16 ? 0 : (u.pm < 32 ? 1 : 2); tab[i * 512 + c.tid] = bias[(size_t)cvv * ldb + u.pn * 256 + (c.tid - 256)]; }
    }
    __syncthreads();
}
template <class Sched> __device__ __forceinline__ void stage_res_vectors(const Ctx& c, const Sched& S, const float* gate, int nh, const float* nw, const float* sc) {
    LAS float* tab = (LAS float*)(c.lds + 132 * 1024);
    pg8::Unit u;
    for (int i = 0; i < 2 && S.next(i, u); ++i)
        for (int idx = c.tid; idx < 1536; idx += NTHREADS) { const int which = idx >= 768 ? 1 : 0, r = idx - which * 768, cvv = r >> 8, col = u.pn * 256 + (r & 255);
            tab[i * 1536 + idx] = which == 0 ? gate[(size_t)cvv * NMOD + col] : (nh ? nw[col] * (1.f + sc[(size_t)cvv * NMOD + col]) : 0.f); }
    __syncthreads();
}
template <int l> __device__ __forceinline__ void run_layer(const Params& p, LAS unsigned char* const lds, const XcdBarrier& bar, int& ph) {
        const int j2 = l >> 1;
        if ((l & 1) == 0) {
            if (PH_ON) { for (int r_ = 0; r_ < REP_NORM; ++r_) { FRESH; if (l == 0) bias_finalize(c); phase_norm<1>(c, l, 0, l == 0); } }
            PH_END;
            if (PH_ON) { for (int r_ = 0; r_ < REP_POOL; ++r_) { FRESH; phase_pool_v(c); } }
            PH_END;
            if (PH_ON) { for (int r_ = 0; r_ < REP_POOL; ++r_) { FRESH; phase_pool_h(c); } }
            PH_END;
            if (PH_ON) { FRESH;
                pg8::Gemm g{(const bf16_t*)(ws + WS_DBUF), (const bf16_t*)(ws + WS_PWT) + (size_t)j2 * 262144, 4 * T, 1024, 256};
                pg8::PoolOrder S{G, c.bid};
                pg8::EpiPool E{(float*)(ws + WS_X), inp(c, I_XP), inp(c, I_XS), l == 0 ? 1 : 0, mod + (size_t)(l * 3) * NMOD + 2 * 1024, inp(c, I_PB) + j2 * 1024, inp(c, I_PS) + j2 * 1024,
                                inp(c, I_NMLP) + l * 1024, mod + (size_t)(l * 3) * NMOD + 4 * 1024, (bf16_t*)(ws + WS_HB), (float*)(ws + WS_ROWSS)};
                pg8::gemm_phase<pg8::EpiPool, pg8::PoolOrder, true, true>(c.lds, g, S, E, c.tid);
            }
            PH_END;
        } else {
            if (PH_ON) { FRESH;
                pg8::Gemm g{(const bf16_t*)(ws + WS_HB), (const bf16_t*)(ws + WS_WINT) + (size_t)j2 * RIN * 1024, T, RIN, 1024};
                pg8::EpiInproj E{(bf16_t*)(ws + WS_Q), (bf16_t*)(ws + WS_K), (bf16_t*)(ws + WS_V), (bf16_t*)(ws + WS_G), (const float*)(ws + WS_TAB + TAB_ROPE), (const LAS float*)(c.lds + 132 * 1024), 0};
                if (G == 256) { pg8::InprojOrder S; S.init(G, c.bid);
                    stage_rstd_bias(c, S, (const float*)(ws + WS_ROWSS), (const float*)(ws + WS_BIASI) + (size_t)j2 * 3 * RIN, RIN);
                    pg8::gemm_phase<pg8::EpiInproj, pg8::InprojOrder, true, true>(c.lds, g, S, E, c.tid); }
                else { pg8::StaticOrder S; S.init(T, RIN, G, c.bid);
                    stage_rstd_bias(c, S, (const float*)(ws + WS_ROWSS), (const float*)(ws + WS_BIASI) + (size_t)j2 * 3 * RIN, RIN);
                    pg8::gemm_phase<pg8::EpiInproj, pg8::StaticOrder, true, true>(c.lds, g, S, E, c.tid); }
            }
            PH_END;
            if (PH_ON) { for (int r_ = 0; r_ < REP_TR; ++r_) { FRESH; phase_tr(c); } }
            PH_END;
            if (PH_ON) { for (int r_ = 0; r_ < REP_R1; ++r_) { FRESH; phase_r1(c, j2); }
                { FRESH;
                  if (G == 256 && c.bid >= 128) { const int idx = c.bid - 128;
                    __syncthreads();
                    pg8::Gemm g{(const bf16_t*)(ws + WS_HB), (const bf16_t*)(ws + WS_WINT) + (size_t)j2 * RIN * 1024, T, RIN, 1024};
                    pg8::SingleOrder S{idx & 15, 16 + (idx >> 4)};
                    pg8::EpiInproj E{(bf16_t*)(ws + WS_Q), (bf16_t*)(ws + WS_K), (bf16_t*)(ws + WS_V), (bf16_t*)(ws + WS_G), (const float*)(ws + WS_TAB + TAB_ROPE), (const LAS float*)(c.lds + 132 * 1024), 0};
                    stage_rstd_bias(c, S, (const float*)(ws + WS_ROWSS), (const float*)(ws + WS_BIASI) + (size_t)j2 * 3 * RIN, RIN);
                    pg8::gemm_phase<pg8::EpiInproj, pg8::SingleOrder, true, true>(c.lds, g, S, E, c.tid); } } }
            PH_END;
            if (PH_ON) { for (int r_ = 0; r_ < REP_R2; ++r_) { FRESH; phase_r2(c, j2); } }
            PH_END;
            if (PH_ON) { FRESH;
                pg8::Gemm g{(const bf16_t*)(ws + WS_A), (const bf16_t*)(ws + WS_WOUTT) + (size_t)j2 * 1024 * HV, T, 1024, HV};
                pg8::StaticOrder S; S.init(T, 1024, G, c.bid); S.nM = T / 192; S.nwg = S.nM * S.nN;
                pg8::EpiRes192 E{(float*)(ws + WS_X), 1, (bf16_t*)(ws + WS_HB), (float*)(ws + WS_ROWSS), (const LAS float*)(c.lds + 132 * 1024), 0};
                stage_res_vectors(c, S, mod + (size_t)(l * 3) * NMOD + 2 * 1024, 1, inp(c, I_NMLP) + l * 1024, mod + (size_t)(l * 3) * NMOD + 4 * 1024);
                pg8::gemm_phase<pg8::EpiRes192, pg8::StaticOrder, true, true, 3>(c.lds, g, S, E, c.tid);
            }
            PH_END;
        }
        if (PH_ON) { FRESH;
            pg8::Gemm g{(const bf16_t*)(ws + WS_HB), (const bf16_t*)(ws + WS_W1T) + (size_t)l * 4096 * 1024, T, FF, 1024};
            pg8::StaticOrder S; S.init(T, FF, G, c.bid);
            pg8::EpiUp E{(bf16_t*)(ws + WS_H), (const LAS float*)(c.lds + 132 * 1024), 0};
            stage_rstd_bias(c, S, (const float*)(ws + WS_ROWSS), (const float*)(ws + WS_BIASU) + (size_t)l * 3 * 4096, 4096);
            for (int r_ = 0; r_ < REP_GEMM_UP; ++r_) { E.ord = 0; pg8::gemm_phase<pg8::EpiUp, pg8::StaticOrder, true, true>(c.lds, g, S, E, c.tid); }
        }
        PH_END;
        if (PH_ON) { FRESH;
            pg8::Gemm g{(const bf16_t*)(ws + WS_H), (const bf16_t*)(ws + WS_W2T) + (size_t)l * 1024 * 4096, T, 1024, FF};
            pg8::StaticOrder S; S.init(T, 1024, G, c.bid); S.nM = T / 192; S.nwg = S.nM * S.nN;
            pg8::EpiRes192 E{(float*)(ws + WS_X), (l & 1) == 0 ? 1 : 0, (bf16_t*)(ws + WS_HB), (float*)(ws + WS_ROWSS), (const LAS float*)(c.lds + 132 * 1024), 0};
            stage_res_vectors(c, S, mod + (size_t)(l * 3) * NMOD + 5 * 1024, (l & 1) == 0 ? 1 : 0, inp(c, I_NMIX) + ((l + 1) & 3) * 1024, mod + (size_t)(((l + 1) & 3) * 3) * NMOD + 1 * 1024);
            for (int r_ = 1; r_ < REP_GEMM_DOWN; ++r_) { pg8::EpiRes192 E2{(float*)(ws + WS_O), 0, (bf16_t*)(ws + WS_HB), (float*)(ws + WS_ROWSS), (const LAS float*)(c.lds + 132 * 1024), 0}; pg8::gemm_phase<pg8::EpiRes192, pg8::StaticOrder, true, true, 3>(c.lds, g, S, E2, c.tid); }
            pg8::gemm_phase<pg8::EpiRes192, pg8::StaticOrder, true, true, 3>(c.lds, g, S, E, c.tid);
        }
        PH_END;
    }
constexpr int N_PHASES = 3 + 2 * 6 + 2 * 7 + 1;
__global__ void __launch_bounds__(NTHREADS) fwd_megakernel(Params p) {
    extern __shared__ __attribute__((aligned(16))) unsigned char lds_raw[];
    cg::grid_group grid = cg::this_grid();
    LAS unsigned char* const lds = (LAS unsigned char*)lds_raw;
    if (p.ph_hi < 0) grid.sync();
    volatile LAS unsigned* const bst = (volatile LAS unsigned*)(lds + LDS_BAR_OFF);
    if (threadIdx.x < 4) bst[threadIdx.x] = 0u;
    __syncthreads();
    XcdBarrier bar = xcd_barrier_post((unsigned*)(p.ws + WS_BAR), bst);
    bar.w0 = __builtin_amdgcn_readfirstlane((int)threadIdx.x >> 6);
    int ph = 0;
    if (PH_ON) { for (int r_ = 0; r_ < REP_P0; ++r_) { FRESH; phase_p0(c); } }
    PH_END;
    if (PH_ON) { FRESH; phase_p0b(c); }
    PH_END;
    if (PH_ON) { for (int r_ = 0; r_ < REP_P0C; ++r_) { FRESH; phase_p0c(c); } }
    PH_END;
    run_layer<0>(p, lds, bar, ph); run_layer<1>(p, lds, bar, ph); run_layer<2>(p, lds, bar, ph); run_layer<3>(p, lds, bar, ph);
    if (PH_ON) { FRESH; phase_norm<2>(c, 0, 0, 0); }
}

extern "C" void kernel_launch(void* const* d_in, const int* in_sizes, int n_in, void* d_out, int out_size, void* d_ws, size_t ws_size, hipStream_t stream) {
    static int grid = 0;
    if (grid == 0) {
        if (n_in != 19 || ws_size < WS_END) { fprintf(stderr, "kernel_launch: unexpected n_in %d / ws_size %zu\n", n_in, ws_size); grid = -1; return; }
        int dev = 0, cus = 0, per_cu = 0;
        hipGetDevice(&dev); hipDeviceGetAttribute(&cus, hipDeviceAttributeMultiprocessorCount, dev);
        if (hipFuncSetAttribute((const void*)fwd_megakernel, hipFuncAttributeMaxDynamicSharedMemorySize, LDS_BYTES) != hipSuccess) { fprintf(stderr, "kernel_launch: hipFuncSetAttribute failed\n"); grid = -1; return; }
        if (hipOccupancyMaxActiveBlocksPerMultiprocessor(&per_cu, (const void*)fwd_megakernel, NTHREADS, LDS_BYTES) != hipSuccess || per_cu < 1) { fprintf(stderr, "kernel_launch: occupancy query says %d\n", per_cu); per_cu = 1; }
        (void)hipGetLastError();
        grid = cus;
    }
    if (grid < 0) return;
    if (hipMemsetAsync((char*)d_ws + WS_BAR, 0, 16384 + 4096, stream) != hipSuccess) { fprintf(stderr, "kernel_launch: memset of barrier words failed\n"); return; }
    Params p{};
    for (int i = 0; i < 19; ++i) p.in[i] = (const float*)d_in[i];
    p.out = (float*)d_out; p.ws = (unsigned char*)d_ws;
#if MULTI_LAUNCH
    for (int k = 0; k < N_PHASES; ++k) { p.ph_lo = k; p.ph_hi = k + 1; hipLaunchKernelGGL(fwd_megakernel, dim3(grid), dim3(NTHREADS), LDS_BYTES, stream, p); }
#else
    p.ph_lo = 0; p.ph_hi = N_PHASES;
    void* args[] = {&p};
    hipError_t e = hipLaunchCooperativeKernel((const void*)fwd_megakernel, dim3(grid), dim3(NTHREADS), args, LDS_BYTES, stream);
    if (e != hipSuccess) fprintf(stderr, "kernel_launch: cooperative launch failed: %s (grid %d)\n", hipGetErrorString(e), grid);
#endif
}
```
